# Optimizing an MI355X kernel written in HIP

```python
import jax, jax.numpy as jnp
from jax import lax
import numpy as np

D_MODEL = 1024
BATCH = 32
SEQ = 256
DEPTH = 4
DEC_BATCH = 2
DEC_SEQ = 2048
PAST_LEN = 512

GRID_W = 64
Q_BLOCK = 128
ROPE_BASE = 10000.0
EPS = 1e-6
N_BRANCH = 4
BRANCH_DIM = 256
RWKV_HEADS = 4
RWKV_HEAD_DIM = 64
RWKV_DIM = RWKV_HEADS * RWKV_HEAD_DIM
RWKV_DECAY_RANK = 64
RWKV_ICLR_RANK = 64
RWKV_GATE_RANK = 128
RWKV_GN_EPS = 64e-5
MLA_HEADS = 4
MLA_NOPE = 64
MLA_ROPE = 32
MLA_VDIM = 64
MLA_Q_RANK = 256
MLA_KV_RANK = 128
GQA_HEADS = 4
GQA_KV_HEADS = 2
GQA_HEAD_DIM = 64
NA_HEADS = 4
NA_HEAD_DIM = 64
NA_DIM = NA_HEADS * NA_HEAD_DIM
NA_WIN_H = 8
NA_WIN_W = 16
FFN_DIM = ((8 * D_MODEL + 3 * 256 - 1) // (3 * 256)) * 256
IN_WIDTHS = (RWKV_DIM, RWKV_DIM, RWKV_DIM, 2 * RWKV_DECAY_RANK, 2 * RWKV_ICLR_RANK, RWKV_GATE_RANK,
             MLA_Q_RANK, MLA_KV_RANK, MLA_ROPE,
             GQA_HEADS * GQA_HEAD_DIM, GQA_KV_HEADS * GQA_HEAD_DIM, GQA_KV_HEADS * GQA_HEAD_DIM,
             NA_DIM, NA_DIM, NA_DIM,
             N_BRANCH * D_MODEL)
N_IN = sum(IN_WIDTHS)

kernel_name = 'hybrid_dit_prefix_context_step'


def rms_norm(x, g):
    xf = x.astype(jnp.float32)
    y = xf * lax.rsqrt(jnp.mean(xf * xf, axis=-1, keepdims=True) + EPS)
    return y.astype(x.dtype) * g


def split_columns(z):
    offsets = np.cumsum(IN_WIDTHS)[:-1].tolist()
    return jnp.split(z, offsets, axis=-1)


def modulation(c_vec, w_mod, b_mod):
    m = (jax.nn.silu(c_vec) @ w_mod + b_mod)[:, None, :]
    return jnp.split(m, 6, axis=-1)


def axial_rope(n_tokens, rot_dim, dtype):
    t = jnp.arange(n_tokens)
    pos = jnp.stack([t // GRID_W, t % GRID_W], axis=-1).astype(jnp.float32)
    n_freq = rot_dim // 4
    inv = ROPE_BASE ** (-jnp.arange(n_freq, dtype=jnp.float32) / n_freq)
    ang = (pos[:, :, None] * inv).reshape(n_tokens, rot_dim // 2)
    return jnp.cos(ang).astype(dtype), jnp.sin(ang).astype(dtype)


def apply_rope(x, cos, sin):
    half = x.shape[-1] // 2
    x1, x2 = x[..., :half], x[..., half:]
    c = cos[None, :, None, :]
    s = sin[None, :, None, :]
    return jnp.concatenate([x1 * c - x2 * s, x1 * s + x2 * c], axis=-1)


def blocked_attention(q, kv_sets, scale):
    Bt, T, KVH, G, Dk = q.shape
    nb = T // Q_BLOCK
    offs = np.cumsum([k.shape[1] for k, _ in kv_sets])[:-1].tolist()
    q_blocks = q.reshape(Bt, nb, Q_BLOCK, KVH, G, Dk).swapaxes(0, 1)

    def one_block(qb):
        s = jnp.concatenate([jnp.einsum('bqkgd,bskd->bkgqs', qb, k) for k, _ in kv_sets], axis=-1)
        p = jax.nn.softmax(s.astype(jnp.float32) * scale, axis=-1).astype(q.dtype)
        o = None
        for pi, (_, v) in zip(jnp.split(p, offs, axis=-1), kv_sets):
            term = jnp.einsum('bkgqs,bskd->bqkgd', pi, v)
            o = term if o is None else o + term
        return o

    o = lax.map(one_block, q_blocks)
    return o.swapaxes(0, 1).reshape(Bt, T, -1)


def neighbourhood_attention(q, k, v, k_ctx, v_ctx, rel_bias):
    Bt, T, H, Dh = q.shape
    rows = T // GRID_W
    win_h = min(NA_WIN_H, rows)
    win_w = NA_WIN_W
    n_win = win_h * win_w
    scale = Dh ** -0.5
    k_grid = k.reshape(Bt, rows, GRID_W, H, Dh)
    v_grid = v.reshape(Bt, rows, GRID_W, H, Dh)
    cols = jnp.arange(GRID_W)
    c0 = jnp.clip(cols - win_w // 2, 0, GRID_W - win_w)
    col_idx = c0[:, None] + jnp.arange(win_w)[None, :]
    bias_cols = rel_bias[:, :, col_idx - cols[:, None] + NA_WIN_W - 1]
    q_rows = q.reshape(Bt, rows, GRID_W, H, Dh).swapaxes(0, 1)

    def one_row(args):
        r, q_r = args
        r0 = jnp.clip(r - win_h // 2, 0, rows - win_h)
        k_win = lax.dynamic_slice_in_dim(k_grid, r0, win_h, axis=1)[:, :, col_idx]
        v_win = lax.dynamic_slice_in_dim(v_grid, r0, win_h, axis=1)[:, :, col_idx]
        bias = jnp.take(bias_cols, r0 + jnp.arange(win_h) - r + NA_WIN_H - 1, axis=1)
        s_win = (jnp.einsum('bqhd,brqwhd->bhqrw', q_r, k_win).astype(jnp.float32) * scale
                 + bias.transpose(0, 2, 1, 3)[None].astype(jnp.float32))
        s_ctx = jnp.einsum('bqhd,blhd->bhql', q_r, k_ctx).astype(jnp.float32) * scale
        s = jnp.concatenate([s_win.reshape(Bt, H, GRID_W, n_win), s_ctx], axis=-1)
        p = jax.nn.softmax(s, axis=-1).astype(q.dtype)
        p_win = p[..., :n_win].reshape(Bt, H, GRID_W, win_h, win_w)
        return (jnp.einsum('bhqrw,brqwhd->bqhd', p_win, v_win)
                + jnp.einsum('bhql,blhd->bqhd', p[..., n_win:], v_ctx))

    o = lax.map(one_row, (jnp.arange(rows), q_rows))
    return o.swapaxes(0, 1).reshape(Bt, T, H * Dh)


def rwkv7_bidirectional(r, k, v, w_lo, a_lo, g_lo, S0, w0, w2, a0, a2, g2, k_k, k_a, r_k, ln_g, ln_b):
    Bt, T, _ = r.shape
    H, N = RWKV_HEADS, RWKV_HEAD_DIM
    w_lo = w_lo.reshape(Bt, T, 2, RWKV_DECAY_RANK)
    a_lo = a_lo.reshape(Bt, T, 2, RWKV_ICLR_RANK)
    w = -jax.nn.softplus(-(w0 + jnp.einsum('btdr,dre->btde', jnp.tanh(w_lo), w2))) - 0.5
    decay = jnp.exp(-jnp.exp(w))
    a = jax.nn.sigmoid(a0 + jnp.einsum('btdr,dre->btde', a_lo, a2))
    g = jax.nn.sigmoid(g_lo) @ g2
    kkf = (k * k_k).reshape(Bt, T, H, N).astype(jnp.float32)
    kk = (kkf * lax.rsqrt(jnp.sum(kkf * kkf, axis=-1, keepdims=True) + 1e-12)).astype(k.dtype).reshape(Bt, T, RWKV_DIM)
    k_dir = k[:, :, None, :] * (1.0 + (a - 1.0) * k_a)

    def scan_layout(u_fwd, u_bwd):
        u = jnp.stack([u_fwd, u_bwd[:, ::-1]], axis=0)
        return u.reshape(2, Bt, T, H, N).transpose(2, 0, 1, 3, 4)

    xs = (scan_layout(r, r), scan_layout(decay[:, :, 0], decay[:, :, 1]),
          scan_layout(k_dir[:, :, 0], k_dir[:, :, 1]), scan_layout(v, v),
          scan_layout(kk, kk), scan_layout(a[:, :, 0], a[:, :, 1]))

    def step(S, inp):
        r_t, w_t, k_t, v_t, kk_t, a_t = inp
        s_a = jnp.einsum('dbhvk,dbhk->dbhv', S, -kk_t)
        S = (S * w_t[..., None, :] + s_a[..., :, None] * (kk_t * a_t)[..., None, :]
             + v_t[..., :, None] * k_t[..., None, :])
        return S, jnp.einsum('dbhvk,dbhk->dbhv', S, r_t)

    S_fin, ys = lax.scan(step, S0, xs)
    y = (ys[:, 0] + ys[::-1, 1]).transpose(1, 0, 2, 3)
    yf = y.astype(jnp.float32)
    mu = jnp.mean(yf, axis=-1, keepdims=True)
    var = jnp.mean(jnp.square(yf - mu), axis=-1, keepdims=True)
    y = ((yf - mu) * lax.rsqrt(var + RWKV_GN_EPS)).astype(r.dtype).reshape(Bt, T, RWKV_DIM) * ln_g + ln_b
    k_mean = k_dir.mean(axis=2)
    bonus = jnp.sum((r * k_mean).reshape(Bt, T, H, N) * r_k, axis=-1, keepdims=True) * v.reshape(Bt, T, H, N)
    return (y + bonus.reshape(Bt, T, RWKV_DIM)) * g, S_fin


def mla_expand(ckv, kpe, w_ukv):
    Bt, S, _ = ckv.shape
    kv = (ckv @ w_ukv).reshape(Bt, S, MLA_HEADS, MLA_NOPE + MLA_VDIM)
    k = jnp.concatenate([kv[..., :MLA_NOPE], jnp.broadcast_to(kpe, (Bt, S, MLA_HEADS, MLA_ROPE))], axis=-1)
    return k, kv[..., MLA_NOPE:]


def mixer_sublayer(x, shift, scale, gate, p, ctx):
    Bt, T, _ = x.shape
    latent = ctx is not None
    h = rms_norm(x, p['norm_mix_pre']) * (1.0 + scale) + shift
    (a_r, a_k, a_v, a_wlo, a_alo, a_glo, m_cq, m_ckv, m_kpe,
     g_q, g_k, g_v, n_q, n_k, n_v, gate_logits) = split_columns(h @ p['w_in'])
    if latent:
        st_rwkv, c_ckv, c_kpe, c_gk, c_gv, c_nk, c_nv = ctx
        S0 = jnp.swapaxes(st_rwkv, 0, 1).astype(x.dtype)
        cos_m, sin_m = axial_rope(T, MLA_ROPE, x.dtype)
        cos_g, sin_g = axial_rope(T, GQA_HEAD_DIM, x.dtype)
    else:
        S0 = jnp.zeros((2, Bt, RWKV_HEADS, RWKV_HEAD_DIM, RWKV_HEAD_DIM), x.dtype)
    y_a, S_fin = rwkv7_bidirectional(a_r, a_k, a_v, a_wlo, a_alo, a_glo, S0, p['rwkv_w0'], p['rwkv_w2'],
                                     p['rwkv_a0'], p['rwkv_a2'], p['rwkv_g2'], p['rwkv_k_k'], p['rwkv_k_a'],
                                     p['rwkv_r_k'], p['rwkv_ln_g'], p['rwkv_ln_b'])
    ckv = rms_norm(m_ckv, p['mla_kv_norm'])
    q_m = (rms_norm(m_cq, p['mla_q_norm']) @ p['mla_w_uq']).reshape(Bt, T, MLA_HEADS, MLA_NOPE + MLA_ROPE)
    kpe = m_kpe[:, :, None, :]
    if latent:
        q_m = jnp.concatenate([q_m[..., :MLA_NOPE], apply_rope(q_m[..., MLA_NOPE:], cos_m, sin_m)], axis=-1)
        kpe = apply_rope(kpe, cos_m, sin_m)
    kv_m = [mla_expand(ckv, kpe, p['mla_w_ukv'])]
    if latent:
        kv_m.append(mla_expand(c_ckv, c_kpe[:, :, None, :], p['mla_w_ukv']))
    y_b = blocked_attention(q_m[:, :, :, None, :], kv_m, (MLA_NOPE + MLA_ROPE) ** -0.5)
    q_g = rms_norm(g_q.reshape(Bt, T, GQA_HEADS, GQA_HEAD_DIM), p['gqa_q_norm'])
    k_g = rms_norm(g_k.reshape(Bt, T, GQA_KV_HEADS, GQA_HEAD_DIM), p['gqa_k_norm'])
    v_g = g_v.reshape(Bt, T, GQA_KV_HEADS, GQA_HEAD_DIM)
    if latent:
        q_g = apply_rope(q_g, cos_g, sin_g)
        kv_g = [(apply_rope(k_g, cos_g, sin_g), v_g), (c_gk, c_gv)]
    else:
        kv_g = [(k_g, v_g)]
    y_c = blocked_attention(q_g.reshape(Bt, T, GQA_KV_HEADS, GQA_HEADS // GQA_KV_HEADS, GQA_HEAD_DIM),
                            kv_g, GQA_HEAD_DIM ** -0.5)
    q_n = n_q.reshape(Bt, T, NA_HEADS, NA_HEAD_DIM)
    k_n = n_k.reshape(Bt, T, NA_HEADS, NA_HEAD_DIM)
    v_n = n_v.reshape(Bt, T, NA_HEADS, NA_HEAD_DIM)
    if latent:
        y_d = neighbourhood_attention(q_n, k_n, v_n, c_nk, c_nv, p['na_rel_bias'])
    else:
        y_d = blocked_attention(q_n[:, :, :, None, :], [(k_n, v_n)], NA_HEAD_DIM ** -0.5)
    ys = jnp.stack([y_a, y_b, y_c, y_d], axis=2)
    proj = jnp.einsum('btnd,nde->btne', ys, p['w_branch'])
    gates = jax.nn.sigmoid(gate_logits).reshape(Bt, T, N_BRANCH, D_MODEL)
    merged = jnp.sum(gates * proj, axis=2) @ p['w_out']
    x = x + gate * rms_norm(merged, p['norm_mix_post'])
    if latent:
        return x, None
    return x, (jnp.swapaxes(S_fin, 0, 1), ckv, m_kpe, k_g, v_g, k_n, v_n)


def ffn_sublayer(x, shift, scale, gate, p):
    h = rms_norm(x, p['norm_ffn_pre']) * (1.0 + scale) + shift
    f = (jax.nn.silu(h @ p['ffn_w_gate']) * (h @ p['ffn_w_up'])) @ p['ffn_w_down']
    return x + gate * rms_norm(f, p['norm_ffn_post'])


def setup_inputs(seed: int = 0) -> dict:
    key = jax.random.key(seed)
    ks = iter(jax.random.split(key, 64))

    def nrm(shape, s=1.0):
        return s * jax.random.normal(next(ks), shape, jnp.float32)

    def gain(shape):
        return 1.0 + 0.01 * jax.random.normal(next(ks), shape, jnp.float32)

    L = DEPTH
    return {
        'x_prompt': nrm((BATCH, SEQ, D_MODEL)),
        'x_sample': nrm((DEC_BATCH, DEC_SEQ, D_MODEL)),
        'c': nrm((DEC_BATCH, D_MODEL)),
        'state_rwkv': nrm((DEC_BATCH, L, 2, RWKV_HEADS, RWKV_HEAD_DIM, RWKV_HEAD_DIM), 0.5),
        'cache_mla_ckv': nrm((DEC_BATCH, L, PAST_LEN, MLA_KV_RANK)),
        'cache_mla_kpe': nrm((DEC_BATCH, L, PAST_LEN, MLA_ROPE)),
        'cache_gqa_k': nrm((DEC_BATCH, L, PAST_LEN, GQA_KV_HEADS, GQA_HEAD_DIM)),
        'cache_gqa_v': nrm((DEC_BATCH, L, PAST_LEN, GQA_KV_HEADS, GQA_HEAD_DIM)),
        'cache_na_k': nrm((DEC_BATCH, L, PAST_LEN, NA_HEADS, NA_HEAD_DIM)),
        'cache_na_v': nrm((DEC_BATCH, L, PAST_LEN, NA_HEADS, NA_HEAD_DIM)),
        'c_ctx': nrm((D_MODEL,)),
        'w_mod': nrm((L, D_MODEL, 6 * D_MODEL), 0.5 * D_MODEL ** -0.5),
        'b_mod': nrm((L, 6 * D_MODEL), 0.01),
        'norm_mix_pre': gain((L, D_MODEL)),
        'norm_mix_post': gain((L, D_MODEL)),
        'norm_ffn_pre': gain((L, D_MODEL)),
        'norm_ffn_post': gain((L, D_MODEL)),
        'w_in': nrm((L, D_MODEL, N_IN), D_MODEL ** -0.5),
        'rwkv_w0': jax.random.uniform(next(ks), (L, 2, RWKV_DIM), jnp.float32, -6.0, 1.0),
        'rwkv_w2': nrm((L, 2, RWKV_DECAY_RANK, RWKV_DIM), 0.5 * RWKV_DECAY_RANK ** -0.5),
        'rwkv_a0': nrm((L, 2, RWKV_DIM), 0.1),
        'rwkv_a2': nrm((L, 2, RWKV_ICLR_RANK, RWKV_DIM), RWKV_ICLR_RANK ** -0.5),
        'rwkv_g2': nrm((L, RWKV_GATE_RANK, RWKV_DIM), RWKV_GATE_RANK ** -0.5),
        'rwkv_k_k': 0.85 + nrm((L, RWKV_DIM), 0.05),
        'rwkv_k_a': 1.0 + nrm((L, RWKV_DIM), 0.05),
        'rwkv_r_k': nrm((L, RWKV_HEADS, RWKV_HEAD_DIM), 0.1),
        'rwkv_ln_g': gain((L, RWKV_DIM)),
        'rwkv_ln_b': nrm((L, RWKV_DIM), 0.01),
        'mla_q_norm': gain((L, MLA_Q_RANK)),
        'mla_w_uq': nrm((L, MLA_Q_RANK, MLA_HEADS * (MLA_NOPE + MLA_ROPE)), MLA_Q_RANK ** -0.5),
        'mla_kv_norm': gain((L, MLA_KV_RANK)),
        'mla_w_ukv': nrm((L, MLA_KV_RANK, MLA_HEADS * (MLA_NOPE + MLA_VDIM)), MLA_KV_RANK ** -0.5),
        'gqa_q_norm': gain((L, GQA_HEAD_DIM)),
        'gqa_k_norm': gain((L, GQA_HEAD_DIM)),
        'na_rel_bias': nrm((L, NA_HEADS, 2 * NA_WIN_H - 1, 2 * NA_WIN_W - 1), 0.1),
        'w_branch': nrm((L, N_BRANCH, BRANCH_DIM, D_MODEL), BRANCH_DIM ** -0.5),
        'w_out': nrm((L, D_MODEL, D_MODEL), D_MODEL ** -0.5),
        'ffn_w_gate': nrm((L, D_MODEL, FFN_DIM), D_MODEL ** -0.5),
        'ffn_w_up': nrm((L, D_MODEL, FFN_DIM), D_MODEL ** -0.5),
        'ffn_w_down': nrm((L, FFN_DIM, D_MODEL), FFN_DIM ** -0.5),
    }


def reference(x_prompt, x_sample, c, state_rwkv, cache_mla_ckv, cache_mla_kpe, cache_gqa_k, cache_gqa_v,
              cache_na_k, cache_na_v, c_ctx, w_mod, b_mod, norm_mix_pre, norm_mix_post, norm_ffn_pre,
              norm_ffn_post, w_in, rwkv_w0, rwkv_w2, rwkv_a0, rwkv_a2, rwkv_g2, rwkv_k_k, rwkv_k_a, rwkv_r_k,
              rwkv_ln_g, rwkv_ln_b, mla_q_norm, mla_w_uq, mla_kv_norm, mla_w_ukv, gqa_q_norm, gqa_k_norm,
              na_rel_bias, w_branch, w_out, ffn_w_gate, ffn_w_up, ffn_w_down):
    P = {'norm_mix_pre': norm_mix_pre, 'norm_mix_post': norm_mix_post, 'norm_ffn_pre': norm_ffn_pre,
         'norm_ffn_post': norm_ffn_post, 'w_in': w_in, 'rwkv_w0': rwkv_w0, 'rwkv_w2': rwkv_w2,
         'rwkv_a0': rwkv_a0, 'rwkv_a2': rwkv_a2, 'rwkv_g2': rwkv_g2, 'rwkv_k_k': rwkv_k_k, 'rwkv_k_a': rwkv_k_a,
         'rwkv_r_k': rwkv_r_k, 'rwkv_ln_g': rwkv_ln_g, 'rwkv_ln_b': rwkv_ln_b, 'mla_q_norm': mla_q_norm,
         'mla_w_uq': mla_w_uq, 'mla_kv_norm': mla_kv_norm, 'mla_w_ukv': mla_w_ukv, 'gqa_q_norm': gqa_q_norm,
         'gqa_k_norm': gqa_k_norm, 'na_rel_bias': na_rel_bias, 'w_branch': w_branch, 'w_out': w_out,
         'ffn_w_gate': ffn_w_gate, 'ffn_w_up': ffn_w_up, 'ffn_w_down': ffn_w_down}

    x = x_prompt
    entries = []
    for l in range(DEPTH):
        p = {name: arr[l] for name, arr in P.items()}
        sh_m, sc_m, gt_m, sh_f, sc_f, gt_f = modulation(c_ctx[None, :], w_mod[l], b_mod[l])
        x, ent = mixer_sublayer(x, sh_m, sc_m, gt_m, p, None)
        entries.append(ent)
        x = ffn_sublayer(x, sh_f, sc_f, gt_f, p)
    y_prompt = x
    new_state_rwkv = jnp.stack([e[0] for e in entries], axis=1)
    new_cache_mla_ckv = jnp.stack([e[1] for e in entries], axis=1)
    new_cache_mla_kpe = jnp.stack([e[2] for e in entries], axis=1)
    new_cache_gqa_k = jnp.stack([e[3] for e in entries], axis=1)
    new_cache_gqa_v = jnp.stack([e[4] for e in entries], axis=1)
    new_cache_na_k = jnp.stack([e[5] for e in entries], axis=1)
    new_cache_na_v = jnp.stack([e[6] for e in entries], axis=1)

    x = x_sample
    for l in range(DEPTH):
        p = {name: arr[l] for name, arr in P.items()}
        sh_m, sc_m, gt_m, sh_f, sc_f, gt_f = modulation(c, w_mod[l], b_mod[l])
        ctx = (state_rwkv[:, l], cache_mla_ckv[:, l], cache_mla_kpe[:, l], cache_gqa_k[:, l],
               cache_gqa_v[:, l], cache_na_k[:, l], cache_na_v[:, l])
        x, _ = mixer_sublayer(x, sh_m, sc_m, gt_m, p, ctx)
        x = ffn_sublayer(x, sh_f, sc_f, gt_f, p)
    y_sample = x
    return (y_prompt, y_sample, new_state_rwkv, new_cache_mla_ckv, new_cache_mla_kpe,
            new_cache_gqa_k, new_cache_gqa_v, new_cache_na_k, new_cache_na_v)
```

```cpp
#include <hip/hip_runtime.h>
#include <hip/hip_cooperative_groups.h>
#include <cstdio>
namespace cg = cooperative_groups;

__device__ __forceinline__ int ltid() { int t = (int)threadIdx.x; asm volatile("" : "+v"(t)); return t; }
__device__ __forceinline__ int lbid() { int t = (int)blockIdx.x; asm volatile("" : "+s"(t)); return t; }
#define TIDX ltid()
#define BIDX lbid()

namespace pg8 {
#define PG8_LAS __attribute__((address_space(3)))
typedef unsigned short bf16_t;
typedef short bf16x8 __attribute__((ext_vector_type(8)));
typedef float f32x4 __attribute__((ext_vector_type(4)));
typedef unsigned u32x4 __attribute__((ext_vector_type(4)));
constexpr int BM = 256, BK = 64, HALF = 128, HTB = HALF * BK * 2  , STAGE_BYTES = 8 * HTB, NXCD = 8, WGM = 8;

__host__ __device__ __forceinline__ int lds_byte(int r, int c) { const int st = (r >> 4) * 2 + (c >> 5), rr = r & 15, cc = c & 31, ob = rr * 64 + cc * 2; return st * 1024 + (ob ^ (((ob >> 9) & 1) << 5)); }
__host__ __device__ __forceinline__ void stage_rc(int b, int& R, int& C) { const int st = b / 1024, sb = b % 1024, swz = sb ^ (((sb >> 9) & 1) << 5); R = (st >> 1) * 16 + swz / 64; C = (st & 1) * 32 + (swz % 64) / 2; }
__host__ __device__ __forceinline__ int perm32(int rho) { const int n = rho >> 4, i = rho & 15; return 8 * (i >> 2) + 4 * n + (i & 3); }

struct Unit { int pm, pn; };
struct Gemm { const bf16_t* A; const bf16_t* Bt; int M, N, K; int ppg; size_t ags; };

struct StaticOrder {
    int nM, nN, nwg, G, c;
    __host__ __device__ void init(int M, int N, int G_, int c_) { nM = M / BM; nN = N / BM; nwg = nM * nN; G = G_; c = c_; }
    __host__ __device__ bool next(int i, Unit& u) const {
        const long L = (long)i * G + c; if (L >= nwg) return false;
        int wgid = (int)L; { const int q = nwg / NXCD, r = nwg % NXCD, xcd = wgid % NXCD, off = wgid / NXCD; wgid = (xcd < r ? xcd * (q + 1) : r * (q + 1) + (xcd - r) * q) + off; }
        const int nig = WGM * nN, gid = wgid / nig, fm = gid * WGM, gsz = (nM - fm) < WGM ? (nM - fm) : WGM;
        u.pm = fm + ((wgid % nig) % gsz); u.pn = (wgid % nig) / gsz; return true;
    }
    __device__ __forceinline__ void a_ready(const Unit&) const {}
    __device__ __forceinline__ void done(const Unit&) const {}
};
__device__ __forceinline__ unsigned cvt_pk_bf16(float lo, float hi) { unsigned r; asm volatile("v_cvt_pk_bf16_f32 %0, %1, %2" : "=v"(r) : "v"(lo), "v"(hi)); return r; }
typedef float f32x2 __attribute__((ext_vector_type(2)));
struct EpiF32 {
    static constexpr bool PERM = false, AFTER_DRAIN = false;
    float* C; int ldc; const float* bias;
    __device__ __forceinline__ void operator()(const f32x4 (&acc)[2][2][4][2], const Unit& u, int wr, int wc, int fr, int fq) const {
        const int row0 = u.pm * BM + wr * 64 + fr, col0 = u.pn * BM + wc * 32 + 4 * fq;
        f32x4 bv[2][2];
#pragma unroll
        for (int bj = 0; bj < 2; ++bj)
#pragma unroll
            for (int n = 0; n < 2; ++n) bv[bj][n] = bias ? *(const f32x4*)(bias + col0 + bj * HALF + n * 16) : (f32x4){0.f, 0.f, 0.f, 0.f};
#pragma unroll
        for (int ai = 0; ai < 2; ++ai)
#pragma unroll
            for (int m = 0; m < 4; ++m) { float* rowp = C + (size_t)(row0 + ai * HALF + m * 16) * ldc + col0;
#pragma unroll
                for (int bj = 0; bj < 2; ++bj)
#pragma unroll
                    for (int n = 0; n < 2; ++n) *(f32x4*)(rowp + bj * HALF + n * 16) = acc[ai][bj][m][n] + bv[bj][n]; }
    }
};
template <class Epi, class Sched, bool STAMP = false>
__device__ __forceinline__ void gemm_phase(PG8_LAS unsigned char* lds, const Gemm g, const Sched& S, const Epi& E, unsigned long long* stamps) {
    const int tid = TIDX, wid = __builtin_amdgcn_readfirstlane(tid >> 6), lane = tid & 63, wr = wid >> 2, wc = wid & 3, fr = lane & 15, fq = lane >> 4;
    const int K = g.K, nt = K / BK;
    int ts_lo = 0, ts_hi = 0, nts = 0;
#define PG8_STAMP() do { if (STAMP && wid == 0 && nts < 64) { const unsigned long long _c = (unsigned long long)clock64(); \
        ts_lo = (lane == nts) ? (int)(unsigned)_c : ts_lo; ts_hi = (lane == nts) ? (int)(unsigned)(_c >> 32) : ts_hi; ++nts; } } while (0)
    PG8_STAMP();
    unsigned voffA[2], voffB[2];
#pragma unroll
    for (int i = 0; i < 2; ++i) { int R, C; stage_rc(tid * 16 + i * 8192, R, C); const int Rb = Epi::PERM ? ((R & ~31) + perm32(R & 31)) : R;
        voffA[i] = (unsigned)(R * K + C) * 2u; voffB[i] = (unsigned)(Rb * K + C) * 2u; }
    const size_t kstep = (size_t)(BK * 2);
    const size_t hstep = (size_t)HALF * K * 2;
    const size_t tstep = 2 * hstep;
    const unsigned ldsw = (unsigned)wid * 1024u;
    const int aoff = lds_byte(wr * 64 + fr, fq * 8), boff = lds_byte(wc * 32 + fr, fq * 8);
#define PG8_SA(b, h) (((b) * 2 + (h)) * HTB)
#define PG8_SB(b, h) ((4 + (b) * 2 + (h)) * HTB)
#define PG8_STAGE(bufoff, gbase, voff) do { _Pragma("unroll") for (int _i = 0; _i < 2; ++_i) \
        __builtin_amdgcn_global_load_lds((const unsigned*)((const char*)(gbase) + (voff)[_i]), (PG8_LAS unsigned*)(lds + (bufoff) + ldsw + _i * 8192), 16, 0, 0); } while (0)
#define PG8_LDA(dst, b, h) do { _Pragma("unroll") for (int m = 0; m < 4; ++m) _Pragma("unroll") for (int k = 0; k < 2; ++k) dst[m][k] = *(const PG8_LAS bf16x8*)(lds + PG8_SA(b, h) + aoff + m * 2048 + k * 1024); } while (0)
#define PG8_LDB(dst, b, h) do { _Pragma("unroll") for (int n = 0; n < 2; ++n) _Pragma("unroll") for (int k = 0; k < 2; ++k) dst[n][k] = *(const PG8_LAS bf16x8*)(lds + PG8_SB(b, h) + boff + n * 2048 + k * 1024); } while (0)
#define PG8_MMA(ai, bj, At, Bt) do { __builtin_amdgcn_s_setprio(1); _Pragma("unroll") for (int m = 0; m < 4; ++m) _Pragma("unroll") for (int n = 0; n < 2; ++n) _Pragma("unroll") for (int k = 0; k < 2; ++k) \
        acc[ai][bj][m][n] = __builtin_amdgcn_mfma_f32_16x16x32_bf16(Bt[n][k], At[m][k], acc[ai][bj][m][n], 0, 0, 0); __builtin_amdgcn_s_setprio(0); } while (0)
#define PG8_WAIT_V(n) asm volatile("s_waitcnt vmcnt(" #n ")" ::: "memory")
#define PG8_WAIT_L(n) asm volatile("s_waitcnt lgkmcnt(" #n ")" ::: "memory")
#define PG8_BAR __builtin_amdgcn_s_barrier()
#define PG8_SCHED __builtin_amdgcn_sched_barrier(0)
    Unit cur, nxt; int ui = 0;
    if (!S.next(0, cur)) return;
    f32x4 acc[2][2][4][2];
#pragma unroll
    for (int a = 0; a < 2; ++a)
#pragma unroll
        for (int b = 0; b < 2; ++b)
#pragma unroll
            for (int m = 0; m < 4; ++m)
#pragma unroll
                for (int n = 0; n < 2; ++n) acc[a][b][m][n] = (f32x4){0.f, 0.f, 0.f, 0.f};
    bf16x8 At[4][2], B0[2][2], B1[2][2];
    const char* cA = (const char*)g.A + (size_t)cur.pm * tstep + (size_t)(cur.pn / g.ppg) * g.ags; const char* cB = (const char*)g.Bt + (size_t)cur.pn * tstep;
    S.a_ready(cur);
    PG8_STAGE(PG8_SB(0, 0), cB, voffB); PG8_STAGE(PG8_SA(0, 0), cA, voffA); PG8_STAGE(PG8_SB(0, 1), cB + hstep, voffB); PG8_STAGE(PG8_SA(0, 1), cA + hstep, voffA);
    if (wr == 1) PG8_BAR;
    PG8_WAIT_V(4); PG8_BAR;
    PG8_STAGE(PG8_SB(1, 0), cB + kstep, voffB); PG8_STAGE(PG8_SA(1, 0), cA + kstep, voffA); PG8_STAGE(PG8_SB(1, 1), cB + hstep + kstep, voffB);
    PG8_WAIT_V(6); PG8_BAR;
    PG8_STAMP();
    for (;;) {
        const bool has_next = S.next(ui + 1, nxt);
        const char* nA = has_next ? (const char*)g.A + (size_t)nxt.pm * tstep + (size_t)(nxt.pn / g.ppg) * g.ags : cA; const char* nB = has_next ? (const char*)g.Bt + (size_t)nxt.pn * tstep : cB;
#pragma unroll 1
        for (int t = 0; t < nt; t += 2) {
            const bool last = (t == nt - 2);
            const char* a1 = cA + (size_t)(t + 1) * kstep;
            const char* a2 = last ? nA : cA + (size_t)(t + 2) * kstep; const char* b2 = last ? nB : cB + (size_t)(t + 2) * kstep;
            const char* a3 = a2 + kstep; const char* b3 = b2 + kstep;
            if (last && has_next) S.a_ready(nxt);
            PG8_LDB(B0, 0, 0); PG8_SCHED; PG8_LDA(At, 0, 0); PG8_STAGE(PG8_SA(1, 1), a1 + hstep, voffA);
            PG8_WAIT_L(8); PG8_BAR; PG8_WAIT_L(0); PG8_MMA(0, 0, At, B0); PG8_BAR; PG8_SCHED;
            PG8_LDB(B1, 0, 1); PG8_STAGE(PG8_SB(0, 0), b2, voffB);
            PG8_BAR; PG8_WAIT_L(0); PG8_MMA(0, 1, At, B1); PG8_BAR;
            PG8_LDA(At, 0, 1); PG8_STAGE(PG8_SA(0, 0), a2, voffA);
            PG8_BAR; PG8_WAIT_L(0); PG8_MMA(1, 0, At, B0); PG8_BAR; PG8_SCHED;
            PG8_STAGE(PG8_SB(0, 1), b2 + hstep, voffB);
            PG8_WAIT_V(6); PG8_BAR; PG8_MMA(1, 1, At, B1); PG8_BAR;
            PG8_LDB(B0, 1, 0); PG8_SCHED; PG8_LDA(At, 1, 0); PG8_STAGE(PG8_SA(0, 1), a2 + hstep, voffA);
            PG8_WAIT_L(8); PG8_BAR; PG8_WAIT_L(0); PG8_MMA(0, 0, At, B0); PG8_BAR; PG8_SCHED;
            PG8_LDB(B1, 1, 1); PG8_STAGE(PG8_SB(1, 0), b3, voffB);
            PG8_BAR; PG8_WAIT_L(0); PG8_MMA(0, 1, At, B1); PG8_BAR;
            PG8_LDA(At, 1, 1); PG8_STAGE(PG8_SA(1, 0), a3, voffA);
            PG8_BAR; PG8_WAIT_L(0); PG8_MMA(1, 0, At, B0); PG8_BAR; PG8_SCHED;
            PG8_STAGE(PG8_SB(1, 1), b3 + hstep, voffB);
            PG8_WAIT_V(6); PG8_BAR; PG8_MMA(1, 1, At, B1); PG8_BAR;
        }
        PG8_STAMP();
        if constexpr (!Epi::AFTER_DRAIN) { E(acc, cur, wr, wc, fr, fq); S.done(cur); }
        PG8_STAMP();
        if (!has_next) break;
#pragma unroll
        for (int a = 0; a < 2; ++a)
#pragma unroll
            for (int b = 0; b < 2; ++b)
#pragma unroll
                for (int m = 0; m < 4; ++m)
#pragma unroll
                    for (int n = 0; n < 2; ++n) acc[a][b][m][n] = (f32x4){0.f, 0.f, 0.f, 0.f};
        cur = nxt; cA = nA; cB = nB; ++ui;
    }
    PG8_WAIT_V(0);
    if (wr == 0) PG8_BAR;
    PG8_BAR;
    if constexpr (Epi::AFTER_DRAIN) { E.fused(acc, cur, wr, wc, fr, fq, lds, wid, lane); S.done(cur); }
    PG8_STAMP();
    if (STAMP && wid == 0) { stamps[lane] = lane < nts ? (((unsigned long long)(unsigned)ts_hi << 32) | (unsigned)ts_lo) : 0ull;
        }
#undef PG8_STAMP
#undef PG8_SA
#undef PG8_SB
#undef PG8_STAGE
#undef PG8_LDA
#undef PG8_LDB
#undef PG8_MMA
#undef PG8_WAIT_V
#undef PG8_WAIT_L
#undef PG8_BAR
#undef PG8_SCHED
}
}

using pg8::bf16_t; using pg8::bf16x8; using pg8::f32x4; using pg8::u32x4;
typedef short s16x4 __attribute__((ext_vector_type(4)));
typedef unsigned u32x2 __attribute__((ext_vector_type(2)));
#define DI __device__ __forceinline__

constexpr int TC = 8192, TLAT = 4096, TT = 12288, DM = 1024, NLAY = 4;
constexpr int NIN = 6944, NZ = 7168, ZBW = 3072, GLW = 4096, FF = 2816;
constexpr int NKEY = 13312;
constexpr int NTHR = 512;
constexpr int LDS_MAIN = 131072, LDS_BYTES = LDS_MAIN + 1024;

constexpr size_t al256(size_t x) { return (x + 255) & ~(size_t)255; }
constexpr size_t WS_CTL = 0;
constexpr size_t WS_MOD = 4096;
constexpr size_t WS_ROPE = WS_MOD + al256((size_t)4 * 3 * 6144 * 4);
constexpr size_t WS_W = WS_ROPE + al256((size_t)(1024 * 2 + 512 * 2) * 4);
constexpr size_t W_IN = WS_W;
constexpr size_t W_BR = W_IN + (size_t)NZ * DM * 2;
constexpr size_t W_O4 = W_BR + (size_t)4096 * 256 * 2;
constexpr size_t W_GU = W_O4 + (size_t)1024 * 4096 * 2;
constexpr size_t W_DN = W_GU + (size_t)5632 * 1024 * 2;
constexpr size_t W_UQ = W_DN + (size_t)1024 * FF * 2;
constexpr size_t W_UKV = W_UQ + (size_t)384 * 256 * 2;
constexpr size_t W_W2 = W_UKV + (size_t)512 * 128 * 2;
constexpr size_t W_A2 = W_W2 + (size_t)2 * 256 * 64 * 2;
constexpr size_t W_G2 = W_A2 + (size_t)2 * 256 * 64 * 2;
constexpr size_t WS_HYS = al256(W_G2 + (size_t)256 * 128 * 2);
constexpr size_t WS_ZB = WS_HYS + (size_t)TT * DM * 2;
constexpr size_t WS_GL = WS_ZB + (size_t)TT * ZBW * 2;
constexpr size_t WS_GP = WS_GL + (size_t)TT * GLW * 2;
constexpr size_t WS_MO = WS_GP + (size_t)TT * GLW * 2;
constexpr size_t WS_END = WS_MO + (size_t)TT * DM * 4;
constexpr size_t SZ_B = (size_t)TT * 256 * 2, SZ_F = (size_t)TT * 256 * 4;
constexpr size_t R_KK = WS_GP, R_KD0 = R_KK + SZ_B, R_KD1 = R_KD0 + SZ_B, R_B0 = R_KD1 + SZ_B, R_B1 = R_B0 + SZ_B;
constexpr size_t R_DEC0 = R_B1 + SZ_B, R_DEC1 = R_DEC0 + SZ_F, R_G = R_DEC1 + SZ_F, R_BS = R_G + SZ_B;
constexpr size_t R_Y0 = R_BS + al256((size_t)TT * 4 * 4), R_Y1 = R_Y0 + SZ_F;
constexpr size_t A_QM = R_Y1 + SZ_F;
constexpr size_t A_KM = A_QM + (size_t)TT * 384 * 2;
constexpr size_t A_VTM = A_KM + (size_t)4 * NKEY * 96 * 2;
constexpr size_t A_QG = A_VTM + (size_t)256 * NKEY * 2;
constexpr size_t A_KG = A_QG + (size_t)TT * 256 * 2;
constexpr size_t A_VTG = A_KG + (size_t)2 * NKEY * 64 * 2;
constexpr size_t A_KN = A_VTG + (size_t)128 * NKEY * 2;
constexpr size_t A_VTN = A_KN + (size_t)4 * NKEY * 64 * 2;
constexpr size_t A_END = A_VTN + (size_t)256 * NKEY * 2;
static_assert(A_END <= WS_END, "branch scratch overflows");

constexpr size_t O_X = 0, O_STATE = 12582912, O_CKV = 16777216, O_KPE = 20971520, O_GK = 22020096, O_GV = 26214400, O_NK = 30408704, O_NV = 38797312;

struct Params { const float* in[40]; float* out; unsigned char* ws; int ph_lo, ph_hi; };

DI float bf2f(bf16_t b) { return __uint_as_float(((unsigned)b) << 16); }
DI bf16_t f2bf(float f) { unsigned u = __float_as_uint(f); u += 0x7FFFu + ((u >> 16) & 1u); return (bf16_t)(u >> 16); }
DI unsigned pk2(float lo, float hi) { return (unsigned)f2bf(lo) | ((unsigned)f2bf(hi) << 16); }
DI float sigmoidf_(float x) { return __builtin_amdgcn_rcpf(1.0f + __expf(-x)); }
template <int CTRL> DI float dppf(float x) { return __int_as_float(__builtin_amdgcn_update_dpp(0, __float_as_int(x), CTRL, 0xf, 0xf, true)); }
DI float rowsum16(float x) { x += dppf<0x128>(x); x += dppf<0x124>(x); x += dppf<0x122>(x); x += dppf<0x121>(x); return x; }
DI float wavesum(float x) { for (int o = 32; o >= 1; o >>= 1) x += __shfl_xor(x, o); return x; }

struct EpiZ {
    static constexpr bool PERM = true, AFTER_DRAIN = false;
    bf16_t* zb; bf16_t* gl;
    DI void operator()(const f32x4 (&acc)[2][2][4][2], const pg8::Unit& u, int wr, int wc, int fr, int fq) const {
        const int row0 = u.pm * 256 + wr * 64 + fr; bf16_t* base; int ldc, colt;
        if (u.pn < 12) { base = zb; ldc = ZBW; colt = u.pn * 256; } else { base = gl; ldc = GLW; colt = (u.pn - 12) * 256; }
        const int col0 = colt + wc * 32 + 8 * fq;
#pragma unroll
        for (int ai = 0; ai < 2; ++ai)
#pragma unroll
            for (int m = 0; m < 4; ++m) { bf16_t* rowp = base + (size_t)(row0 + ai * 128 + m * 16) * ldc + col0;
#pragma unroll
                for (int bj = 0; bj < 2; ++bj) { const f32x4 v0 = acc[ai][bj][m][0], v1 = acc[ai][bj][m][1];
                    u32x4 w; w.x = pg8::cvt_pk_bf16(v0[0], v0[1]); w.y = pg8::cvt_pk_bf16(v0[2], v0[3]); w.z = pg8::cvt_pk_bf16(v1[0], v1[1]); w.w = pg8::cvt_pk_bf16(v1[2], v1[3]);
                    *(u32x4*)(rowp + bj * 128) = w; } }
    }
};
struct EpiGate {
    static constexpr bool PERM = true, AFTER_DRAIN = false;
    const bf16_t* gl; bf16_t* gp;
    DI void operator()(const f32x4 (&acc)[2][2][4][2], const pg8::Unit& u, int wr, int wc, int fr, int fq) const {
        const int row0 = u.pm * 256 + wr * 64 + fr; const int col0 = u.pn * 256 + wc * 32 + 8 * fq;
#pragma unroll
        for (int ai = 0; ai < 2; ++ai)
#pragma unroll
            for (int m = 0; m < 4; ++m) {
#pragma unroll
                for (int bj = 0; bj < 2; ++bj) { const size_t off = (size_t)(row0 + ai * 128 + m * 16) * GLW + col0 + bj * 128;
                    const u32x4 gw = *(const u32x4*)(gl + off); u32x4 w;
                    { const f32x4 v = acc[ai][bj][m][0];
                      w.x = pg8::cvt_pk_bf16(v[0] * sigmoidf_(__uint_as_float(gw.x << 16)), v[1] * sigmoidf_(__uint_as_float(gw.x & 0xffff0000u)));
                      w.y = pg8::cvt_pk_bf16(v[2] * sigmoidf_(__uint_as_float(gw.y << 16)), v[3] * sigmoidf_(__uint_as_float(gw.y & 0xffff0000u))); }
                    { const f32x4 v = acc[ai][bj][m][1];
                      w.z = pg8::cvt_pk_bf16(v[0] * sigmoidf_(__uint_as_float(gw.z << 16)), v[1] * sigmoidf_(__uint_as_float(gw.z & 0xffff0000u)));
                      w.w = pg8::cvt_pk_bf16(v[2] * sigmoidf_(__uint_as_float(gw.w << 16)), v[3] * sigmoidf_(__uint_as_float(gw.w & 0xffff0000u))); }
                    *(u32x4*)(gp + off) = w;
                    asm volatile("" ::: "memory"); } }
    }
};
struct EpiSwiGLU {
    static constexpr bool PERM = false, AFTER_DRAIN = false;
    bf16_t* act;
    DI void operator()(const f32x4 (&acc)[2][2][4][2], const pg8::Unit& u, int wr, int wc, int fr, int fq) const {
        const int row0 = u.pm * 256 + wr * 64 + fr; const int col0 = (u.pn * 256 + wc * 32) / 2 + 4 * fq;
#pragma unroll
        for (int ai = 0; ai < 2; ++ai)
#pragma unroll
            for (int m = 0; m < 4; ++m) { bf16_t* rowp = act + (size_t)(row0 + ai * 128 + m * 16) * FF + col0;
#pragma unroll
                for (int bj = 0; bj < 2; ++bj) { const f32x4 g = acc[ai][bj][m][0], up = acc[ai][bj][m][1];
                    u32x2 w; w.x = pg8::cvt_pk_bf16(g[0] * sigmoidf_(g[0]) * up[0], g[1] * sigmoidf_(g[1]) * up[1]);
                    w.y = pg8::cvt_pk_bf16(g[2] * sigmoidf_(g[2]) * up[2], g[3] * sigmoidf_(g[3]) * up[3]);
                    *(u32x2*)(rowp + bj * 64) = w; } }
    }
};

typedef const float* cfp_t;
typedef const cfp_t __attribute__((address_space(4)))* KIn;
struct Ctx {
    KIn in; float* out; unsigned char* ws; unsigned char* smem;
    template <class T> DI T* w(size_t off) const { return (T*)(ws + off); }
};

DI void phase_mod(const Ctx& C) {
    const int tid = TIDX;
    float* sc = (float*)C.smem;
    float* red = sc + 3072;
    for (int i = tid; i < 3072; i += NTHR) { const int j = i >> 10, k = i & 1023; const float v = (j == 0) ? C.in[10][k] : C.in[2][(j - 1) * 1024 + k]; sc[i] = v * sigmoidf_(v); }
    __syncthreads();
    float* mod = C.w<float>(WS_MOD);
    for (int item = BIDX; item < 4 * 48; item += gridDim.x) {
        const int l = item / 48, cb = item % 48, col = cb * 128 + (tid & 127), kg = tid >> 7;
        const float* wp = C.in[11] + ((size_t)l * 1024 + kg * 256) * 6144 + col;
        float a0 = 0.f, a1 = 0.f, a2 = 0.f;
#pragma unroll 8
        for (int k = 0; k < 256; ++k) { const float w = wp[(size_t)k * 6144]; a0 += sc[kg * 256 + k] * w; a1 += sc[1024 + kg * 256 + k] * w; a2 += sc[2048 + kg * 256 + k] * w; }
        red[(kg * 3 + 0) * 128 + (tid & 127)] = a0; red[(kg * 3 + 1) * 128 + (tid & 127)] = a1; red[(kg * 3 + 2) * 128 + (tid & 127)] = a2;
        __syncthreads();
        if (tid < 384) { const int j = tid >> 7, c = tid & 127; const float s = red[(0 * 3 + j) * 128 + c] + red[(1 * 3 + j) * 128 + c] + red[(2 * 3 + j) * 128 + c] + red[(3 * 3 + j) * 128 + c];
            mod[((size_t)l * 3 + j) * 6144 + cb * 128 + c] = s + C.in[12][l * 6144 + cb * 128 + c]; }
        __syncthreads();
    }
    if (BIDX == gridDim.x - 1) {
        float* rp = C.w<float>(WS_ROPE);
        for (int i = tid; i < 1024; i += NTHR) { const int p = i >> 4, f = i & 15; const float inv = powf(10000.0f, -(float)f / 16.0f); const float a = (float)p * inv; rp[i] = cosf(a); rp[1024 + i] = sinf(a); }
        for (int i = tid; i < 512; i += NTHR) { const int p = i >> 3, f = i & 7; const float inv = powf(10000.0f, -(float)f / 8.0f); const float a = (float)p * inv; rp[2048 + i] = cosf(a); rp[2560 + i] = sinf(a); }
    }
}

DI void conv_job(const Ctx& C, const float* src, bf16_t* dst, int K, int N, int ld, int mode) {
    float* tile = (float*)C.smem;
    const int tid = TIDX, nk = K / 64, nn = (N + 63) / 64;
    for (int t = BIDX; t < nk * nn; t += gridDim.x) {
        const int k0 = (t % nk) * 64, n0 = (t / nk) * 64;
#pragma unroll
        for (int i = 0; i < 2; ++i) { const int k = (tid >> 4) + 32 * i, n4 = (tid & 15) * 4;
            f32x4 v = {0.f, 0.f, 0.f, 0.f}; if (n0 + n4 < N) v = *(const f32x4*)(src + (size_t)(k0 + k) * N + n0 + n4);
            tile[k * 65 + n4] = v[0]; tile[k * 65 + n4 + 1] = v[1]; tile[k * 65 + n4 + 2] = v[2]; tile[k * 65 + n4 + 3] = v[3]; }
        __syncthreads();
        { const int n = tid >> 3, k8 = (tid & 7) * 8, ng = n0 + n;
          if (ng < N) {
            u32x4 w; w.x = pk2(tile[(k8 + 0) * 65 + n], tile[(k8 + 1) * 65 + n]); w.y = pk2(tile[(k8 + 2) * 65 + n], tile[(k8 + 3) * 65 + n]);
            w.z = pk2(tile[(k8 + 4) * 65 + n], tile[(k8 + 5) * 65 + n]); w.w = pk2(tile[(k8 + 6) * 65 + n], tile[(k8 + 7) * 65 + n]);
            int row = ng;
            if (mode == 1) row = ng < 2848 ? ng : ng + 224;
            else if (mode == 3) row = (ng >> 4) * 32 + (ng & 15);
            else if (mode == 4) row = (ng >> 4) * 32 + 16 + (ng & 15);
            bf16_t* dp = dst + (size_t)row * ld + k0 + k8;
            *(u32x4*)dp = w;
            if (mode == 2) { *(u32x4*)(dp + 1024) = w; *(u32x4*)(dp + 2048) = w; *(u32x4*)(dp + 3072) = w; }
          } }
        __syncthreads();
    }
}
DI void phase_convert(const Ctx& C, int l) {
    { bf16_t* z = C.w<bf16_t>(W_IN) + (size_t)2848 * 1024;
      for (int i = BIDX * NTHR + TIDX; i < 224 * 1024 / 8; i += gridDim.x * NTHR) *(u32x4*)(z + (size_t)i * 8) = (u32x4){0u, 0u, 0u, 0u}; }
    conv_job(C, C.in[17] + (size_t)l * 1024 * NIN, C.w<bf16_t>(W_IN), 1024, NIN, 1024, 1);
    for (int n = 0; n < 4; ++n) conv_job(C, C.in[35] + ((size_t)l * 4 + n) * 256 * 1024, C.w<bf16_t>(W_BR) + (size_t)n * 1024 * 256, 256, 1024, 256, 0);
    conv_job(C, C.in[36] + (size_t)l * 1024 * 1024, C.w<bf16_t>(W_O4), 1024, 1024, 4096, 2);
    conv_job(C, C.in[37] + (size_t)l * 1024 * FF, C.w<bf16_t>(W_GU), 1024, FF, 1024, 3);
    conv_job(C, C.in[38] + (size_t)l * 1024 * FF, C.w<bf16_t>(W_GU), 1024, FF, 1024, 4);
    conv_job(C, C.in[39] + (size_t)l * FF * 1024, C.w<bf16_t>(W_DN), FF, 1024, FF, 0);
    conv_job(C, C.in[29] + (size_t)l * 256 * 384, C.w<bf16_t>(W_UQ), 256, 384, 256, 0);
    conv_job(C, C.in[31] + (size_t)l * 128 * 512, C.w<bf16_t>(W_UKV), 128, 512, 128, 0);
    for (int d = 0; d < 2; ++d) {
        conv_job(C, C.in[19] + ((size_t)l * 2 + d) * 64 * 256, C.w<bf16_t>(W_W2) + (size_t)d * 256 * 64, 64, 256, 64, 0);
        conv_job(C, C.in[21] + ((size_t)l * 2 + d) * 64 * 256, C.w<bf16_t>(W_A2) + (size_t)d * 256 * 64, 64, 256, 64, 0);
    }
    conv_job(C, C.in[22] + (size_t)l * 128 * 256, C.w<bf16_t>(W_G2), 128, 256, 128, 0);
}

DI void phase_rowprep(const Ctx& C, int mode, int l) {
    const int lane = TIDX & 63, wave = TIDX >> 6;
    const float* mod = C.w<float>(WS_MOD); const float* mo = C.w<float>(WS_MO); bf16_t* h = C.w<bf16_t>(WS_HYS);
    const int lh = (mode == 0) ? 0 : (mode == 1 ? l : (l + 1 < NLAY ? l + 1 : -1));
    const float* gpost = (mode == 1) ? C.in[14] + l * 1024 : C.in[16] + l * 1024;
    const float* gpre = (mode == 1) ? C.in[15] + l * 1024 : C.in[13] + (lh < 0 ? 0 : lh) * 1024;
    const int goff = (mode == 1) ? 2048 : 5120, shoff = (mode == 1) ? 3072 : 0, scoff = (mode == 1) ? 4096 : 1024;
    for (int t = BIDX * 8 + wave; t < TT; t += gridDim.x * 8) {
        const int j = t < TC ? 0 : 1 + (t - TC) / 2048;
        f32x4 x[4];
        if (mode == 0) { const float* src = t < TC ? C.in[0] + (size_t)t * 1024 : C.in[1] + (size_t)(t - TC) * 1024;
#pragma unroll
            for (int i = 0; i < 4; ++i) x[i] = *(const f32x4*)(src + i * 256 + lane * 4); }
        else {
            const float* mg = mod + ((size_t)l * 3 + j) * 6144 + goff;
            f32x4 y[4]; float ss = 0.f;
#pragma unroll
            for (int i = 0; i < 4; ++i) { y[i] = *(const f32x4*)(mo + (size_t)t * 1024 + i * 256 + lane * 4); x[i] = *(const f32x4*)(C.out + (size_t)t * 1024 + i * 256 + lane * 4); ss += y[i][0] * y[i][0] + y[i][1] * y[i][1] + y[i][2] * y[i][2] + y[i][3] * y[i][3]; }
            ss = wavesum(ss); const float rs = rsqrtf(ss * (1.0f / 1024.0f) + 1e-6f);
#pragma unroll
            for (int i = 0; i < 4; ++i) { const f32x4 gp = *(const f32x4*)(gpost + i * 256 + lane * 4), gt = *(const f32x4*)(mg + i * 256 + lane * 4); x[i] = x[i] + gt * (y[i] * rs * gp); }
        }
#pragma unroll
        for (int i = 0; i < 4; ++i) *(f32x4*)(C.out + (size_t)t * 1024 + i * 256 + lane * 4) = x[i];
        if (lh >= 0) {
            const float* mb = mod + ((size_t)lh * 3 + j) * 6144;
            float ss = 0.f;
#pragma unroll
            for (int i = 0; i < 4; ++i) ss += x[i][0] * x[i][0] + x[i][1] * x[i][1] + x[i][2] * x[i][2] + x[i][3] * x[i][3];
            ss = wavesum(ss); const float rs = rsqrtf(ss * (1.0f / 1024.0f) + 1e-6f);
#pragma unroll
            for (int i = 0; i < 4; ++i) { const f32x4 g = *(const f32x4*)(gpre + i * 256 + lane * 4), sc = *(const f32x4*)(mb + scoff + i * 256 + lane * 4), sh = *(const f32x4*)(mb + shoff + i * 256 + lane * 4);
                const f32x4 hv = (x[i] * rs * g) * (sc + 1.0f) + sh; u32x2 w; w.x = pk2(hv[0], hv[1]); w.y = pk2(hv[2], hv[3]);
                *(u32x2*)(h + (size_t)t * 1024 + i * 256 + lane * 4) = w; }
        }
    }
}

constexpr int ZT_LD = 2856;
template <int K> DI f32x4 tile_gemm(const bf16_t* zt, int acol, const bf16_t* Bt, int n0, int lane) {
    f32x4 acc = {0.f, 0.f, 0.f, 0.f}; const int r = lane & 15, q = lane >> 4;
    const bf16_t* ap = zt + r * ZT_LD + acol + q * 8; const bf16_t* bp = Bt + (size_t)(n0 + r) * K + q * 8;
#pragma unroll
    for (int ks = 0; ks < K / 32; ++ks) { const bf16x8 a = *(const bf16x8*)(ap + ks * 32); const bf16x8 b = *(const bf16x8*)(bp + ks * 32); acc = __builtin_amdgcn_mfma_f32_16x16x32_bf16(a, b, acc, 0, 0, 0); }
    return acc;
}
DI float red_xor(float v, int span) { for (int o = 1; o < span; o <<= 1) v += __shfl_xor(v, o); return v; }

DI void prep_tile(const Ctx& C, int l, int item) {
    bf16_t* ZT = (bf16_t*)C.smem; float* KKs = (float*)(C.smem + 91392); float* PART = (float*)(C.smem + 91392 + 16384);
    const int tid = TIDX, lane = tid & 63, wave = tid >> 6, r16 = lane & 15, quad = lane >> 4;
    const bool cached = item >= 768;
    int t0, kidx0, seq, pos0; bool latent;
    if (!cached) { t0 = item * 16; latent = t0 >= TC; if (!latent) { seq = t0 >> 8; pos0 = t0 & 255; kidx0 = t0; } else { const int u = t0 - TC; seq = 32 + (u >> 11); pos0 = u & 2047; kidx0 = TC + (u >> 11) * 2560 + pos0; } }
    else { const int ct = item - 768, b = ct >> 5; pos0 = (ct & 31) * 16; seq = 32 + b; kidx0 = TC + b * 2560 + 2048 + pos0; latent = true; t0 = 0; }
    const bf16_t* zb = C.w<bf16_t>(WS_ZB);
    if (!cached) {
        for (int i = tid; i < 16 * 356; i += NTHR) { const int row = i / 356, ch = i % 356; *(u32x4*)(ZT + row * ZT_LD + ch * 8) = *(const u32x4*)(zb + (size_t)(t0 + row) * ZBW + ch * 8); }
    } else {
        const int b = seq - 32; const size_t rb = ((size_t)b * 4 + l) * 512 + pos0;
        for (int i = tid; i < 16 * 928; i += NTHR) { const int row = i / 928, e = i % 928; float v; int col;
            if (e < 128) { v = C.in[4][(rb + row) * 128 + e]; col = 1408 + e; }
            else if (e < 160) { v = C.in[5][(rb + row) * 32 + (e - 128)]; col = 1536 + (e - 128); }
            else if (e < 288) { v = C.in[6][(rb + row) * 128 + (e - 160)]; col = 1824 + (e - 160); }
            else if (e < 416) { v = C.in[7][(rb + row) * 128 + (e - 288)]; col = 1952 + (e - 288); }
            else if (e < 672) { v = C.in[8][(rb + row) * 256 + (e - 416)]; col = 2336 + (e - 416); }
            else { v = C.in[9][(rb + row) * 256 + (e - 672)]; col = 2592 + (e - 672); }
            ZT[row * ZT_LD + col] = f2bf(v); }
    }
    __syncthreads();
    const float* rope = C.w<float>(WS_ROPE);
    if (!cached) {
        const int tok = tid >> 5, sub = tid & 31, t = t0 + tok, pos = pos0 + tok; bf16_t* zr = ZT + tok * ZT_LD;
        const size_t crow = ((size_t)seq * 4 + l) * 256 + pos;
#pragma unroll
        for (int i = 0; i < 4; ++i) { const int c = sub * 4 + i; zr[768 + c] = f2bf(tanhf(bf2f(zr[768 + c]))); zr[1024 + c] = f2bf(sigmoidf_(bf2f(zr[1024 + c]))); }
        { float x[8]; float ss = 0.f;
#pragma unroll
          for (int i = 0; i < 8; ++i) { x[i] = bf2f(zr[1152 + sub * 8 + i]); ss += x[i] * x[i]; }
          ss = red_xor(ss, 32); const float rs = rsqrtf(ss * (1.0f / 256.0f) + 1e-6f);
#pragma unroll
          for (int i = 0; i < 8; ++i) zr[1152 + sub * 8 + i] = f2bf(x[i] * rs * C.in[28][l * 256 + sub * 8 + i]); }
        { float x[4]; float ss = 0.f;
#pragma unroll
          for (int i = 0; i < 4; ++i) { x[i] = bf2f(zr[1408 + sub * 4 + i]); ss += x[i] * x[i]; }
          ss = red_xor(ss, 32); const float rs = rsqrtf(ss * (1.0f / 128.0f) + 1e-6f);
#pragma unroll
          for (int i = 0; i < 4; ++i) { const float y = x[i] * rs * C.in[30][l * 128 + sub * 4 + i]; zr[1408 + sub * 4 + i] = f2bf(y); if (!latent) C.out[O_CKV + crow * 128 + sub * 4 + i] = y; } }
        { float x[8]; float ss = 0.f;
#pragma unroll
          for (int i = 0; i < 8; ++i) { x[i] = bf2f(zr[256 + sub * 8 + i]) * C.in[23][l * 256 + sub * 8 + i]; ss += x[i] * x[i]; }
          ss = red_xor(ss, 8); const float rs = rsqrtf(ss + 1e-12f);
          bf16_t* kkg = C.w<bf16_t>(R_KK) + (size_t)t * 256 + sub * 8;
#pragma unroll
          for (int i = 0; i < 8; ++i) { const float y = x[i] * rs; KKs[tok * 256 + sub * 8 + i] = y; kkg[i] = f2bf(y); } }
        { float x[8]; float ss = 0.f;
#pragma unroll
          for (int i = 0; i < 8; ++i) { x[i] = bf2f(zr[1568 + sub * 8 + i]); ss += x[i] * x[i]; }
          ss = red_xor(ss, 8); const float rs = rsqrtf(ss * (1.0f / 64.0f) + 1e-6f);
#pragma unroll
          for (int i = 0; i < 8; ++i) zr[1568 + sub * 8 + i] = f2bf(x[i] * rs * C.in[32][l * 64 + (sub & 7) * 8 + i]); }
        { float x[4]; float ss = 0.f;
#pragma unroll
          for (int i = 0; i < 4; ++i) { x[i] = bf2f(zr[1824 + sub * 4 + i]); ss += x[i] * x[i]; }
          ss = red_xor(ss, 16); const float rs = rsqrtf(ss * (1.0f / 64.0f) + 1e-6f);
#pragma unroll
          for (int i = 0; i < 4; ++i) { const float y = x[i] * rs * C.in[33][l * 64 + (sub & 15) * 4 + i]; zr[1824 + sub * 4 + i] = f2bf(y); if (!latent) C.out[O_GK + crow * 128 + sub * 4 + i] = y; } }
        if (!latent) {
            C.out[O_KPE + crow * 32 + sub] = bf2f(zr[1536 + sub]);
#pragma unroll
            for (int i = 0; i < 4; ++i) C.out[O_GV + crow * 128 + sub * 4 + i] = bf2f(zr[1952 + sub * 4 + i]);
#pragma unroll
            for (int i = 0; i < 8; ++i) { C.out[O_NK + crow * 256 + sub * 8 + i] = bf2f(zr[2336 + sub * 8 + i]); C.out[O_NV + crow * 256 + sub * 8 + i] = bf2f(zr[2592 + sub * 8 + i]); }
        }
        __syncthreads();
        if (latent) {
            if (tid < 256) { const int tk = tid >> 4, i = tid & 15, p = pos0 + tk, pi = (i < 8) ? (p >> 6) : (p & 63), f = i & 7;
                const float cs = rope[2048 + pi * 8 + f], sn = rope[2560 + pi * 8 + f]; bf16_t* z = ZT + tk * ZT_LD + 1536;
                const float x1 = bf2f(z[i]), x2 = bf2f(z[16 + i]); z[i] = f2bf(x1 * cs - x2 * sn); z[16 + i] = f2bf(x1 * sn + x2 * cs); }
            for (int e = tid; e < 16 * 6 * 32; e += NTHR) { const int tk = e / 192, r = e % 192, hd = r >> 5, i = r & 31, p = pos0 + tk, pi = (i < 16) ? (p >> 6) : (p & 63), f = i & 15;
                const float cs = rope[pi * 16 + f], sn = rope[1024 + pi * 16 + f]; bf16_t* z = ZT + tk * ZT_LD + (hd < 4 ? 1568 + hd * 64 : 1824 + (hd - 4) * 64);
                const float x1 = bf2f(z[i]), x2 = bf2f(z[32 + i]); z[i] = f2bf(x1 * cs - x2 * sn); z[32 + i] = f2bf(x1 * sn + x2 * cs); }
            __syncthreads();
        }
    }
    if (tid < 256) { const int tk = tid >> 4, hd = (tid >> 2) & 3, ch = tid & 3;
        *(u32x4*)(C.w<bf16_t>(A_KM) + ((size_t)hd * NKEY + kidx0 + tk) * 96 + 64 + ch * 8) = *(const u32x4*)(ZT + tk * ZT_LD + 1536 + ch * 8); }
    if (!cached) { const int tk = tid >> 5, ch = tid & 31; *(u32x4*)(C.w<bf16_t>(A_QG) + (size_t)(t0 + tk) * 256 + ch * 8) = *(const u32x4*)(ZT + tk * ZT_LD + 1568 + ch * 8); }
    if (tid < 256) { const int tk = tid >> 4, hd = (tid >> 3) & 1, ch = tid & 7;
        *(u32x4*)(C.w<bf16_t>(A_KG) + ((size_t)hd * NKEY + kidx0 + tk) * 64 + ch * 8) = *(const u32x4*)(ZT + tk * ZT_LD + 1824 + hd * 64 + ch * 8); }
    { const int tk = tid >> 5, hd = (tid >> 3) & 3, ch = tid & 7;
        *(u32x4*)(C.w<bf16_t>(A_KN) + ((size_t)hd * NKEY + kidx0 + tk) * 64 + ch * 8) = *(const u32x4*)(ZT + tk * ZT_LD + 2336 + hd * 64 + ch * 8); }
    { const int col = tid >> 2, tg = tid & 3; const bf16_t* z = ZT + (tg * 4) * ZT_LD + 1952 + col;
        u32x2 w; w.x = (unsigned)z[0] | ((unsigned)z[ZT_LD] << 16); w.y = (unsigned)z[2 * ZT_LD] | ((unsigned)z[3 * ZT_LD] << 16);
        *(u32x2*)(C.w<bf16_t>(A_VTG) + (size_t)col * NKEY + kidx0 + tg * 4) = w; }
#pragma unroll
    for (int rep = 0; rep < 2; ++rep) { const int it = tid + rep * NTHR, col = it >> 2, tg = it & 3; const bf16_t* z = ZT + (tg * 4) * ZT_LD + 2592 + col;
        u32x2 w; w.x = (unsigned)z[0] | ((unsigned)z[ZT_LD] << 16); w.y = (unsigned)z[2 * ZT_LD] | ((unsigned)z[3 * ZT_LD] << 16);
        *(u32x2*)(C.w<bf16_t>(A_VTN) + (size_t)col * NKEY + kidx0 + tg * 4) = w; }
    {
#pragma unroll
        for (int i = 0; i < 4; ++i) { const int nt = wave * 4 + i, hd = nt >> 3, sb = nt & 7;
            const f32x4 acc = tile_gemm<128>(ZT, 1408, C.w<bf16_t>(W_UKV), nt * 16, lane);
            if (sb < 4) { bf16_t* kp = C.w<bf16_t>(A_KM) + ((size_t)hd * NKEY + kidx0 + quad * 4) * 96 + sb * 16 + r16;
#pragma unroll
                for (int j = 0; j < 4; ++j) kp[j * 96] = f2bf(acc[j]); }
            else { u32x2 w; w.x = pk2(acc[0], acc[1]); w.y = pk2(acc[2], acc[3]);
                *(u32x2*)(C.w<bf16_t>(A_VTM) + ((size_t)hd * 64 + (sb - 4) * 16 + r16) * NKEY + kidx0 + quad * 4) = w; } }
    }
    if (!cached) {
        {
            const int d = wave >> 2; float* dec = C.w<float>(d ? R_DEC1 : R_DEC0);
#pragma unroll
            for (int i = 0; i < 4; ++i) { const int nt = (wave & 3) * 4 + i, c = nt * 16 + r16;
                const f32x4 acc = tile_gemm<64>(ZT, 768 + d * 64, C.w<bf16_t>(W_W2) + (size_t)d * 256 * 64, nt * 16, lane);
                const float w0 = C.in[18][((size_t)l * 2 + d) * 256 + c];
#pragma unroll
                for (int j = 0; j < 4; ++j) { const float x = -(w0 + acc[j]); const float sp = fmaxf(x, 0.f) + log1pf(__expf(-fabsf(x))); const float w = -sp - 0.5f;
                    dec[(size_t)(t0 + quad * 4 + j) * 256 + c] = __expf(-__expf(w)); } }
        }
        {
#pragma unroll
            for (int i = 0; i < 2; ++i) { const int nt = wave * 2 + i, c = nt * 16 + r16;
                const f32x4 ac0 = tile_gemm<64>(ZT, 896, C.w<bf16_t>(W_A2), nt * 16, lane);
                const f32x4 ac1 = tile_gemm<64>(ZT, 960, C.w<bf16_t>(W_A2) + (size_t)256 * 64, nt * 16, lane);
                const float a00 = C.in[20][((size_t)l * 2 + 0) * 256 + c], a01 = C.in[20][((size_t)l * 2 + 1) * 256 + c], ka = C.in[24][l * 256 + c], rk = C.in[25][l * 256 + c];
#pragma unroll
                for (int j = 0; j < 4; ++j) { const int tk = quad * 4 + j; const size_t o = (size_t)(t0 + tk) * 256 + c;
                    const float a0 = sigmoidf_(a00 + ac0[j]), a1 = sigmoidf_(a01 + ac1[j]);
                    const float k = bf2f(ZT[tk * ZT_LD + 256 + c]), r = bf2f(ZT[tk * ZT_LD + c]), kk = KKs[tk * 256 + c];
                    const float kd0 = k * (1.0f + (a0 - 1.0f) * ka), kd1 = k * (1.0f + (a1 - 1.0f) * ka);
                    C.w<bf16_t>(R_KD0)[o] = f2bf(kd0); C.w<bf16_t>(R_KD1)[o] = f2bf(kd1); C.w<bf16_t>(R_B0)[o] = f2bf(kk * a0); C.w<bf16_t>(R_B1)[o] = f2bf(kk * a1);
                    const float part = rowsum16(r * 0.5f * (kd0 + kd1) * rk);
                    if (r16 == 0) PART[tk * 16 + nt] = part; } }
        }
        {
#pragma unroll
            for (int i = 0; i < 2; ++i) { const int nt = wave * 2 + i, c = nt * 16 + r16;
                const f32x4 acc = tile_gemm<128>(ZT, 1024, C.w<bf16_t>(W_G2), nt * 16, lane);
#pragma unroll
                for (int j = 0; j < 4; ++j) C.w<bf16_t>(R_G)[(size_t)(t0 + quad * 4 + j) * 256 + c] = f2bf(acc[j]); }
        }
        {
            const int hd = wave >> 1, tb = (wave & 1) * 3; bf16_t* qm = C.w<bf16_t>(A_QM);
            f32x4 a0 = tile_gemm<256>(ZT, 1152, C.w<bf16_t>(W_UQ), hd * 96 + (tb + 0) * 16, lane);
            f32x4 a1 = tile_gemm<256>(ZT, 1152, C.w<bf16_t>(W_UQ), hd * 96 + (tb + 1) * 16, lane);
            f32x4 a2 = tile_gemm<256>(ZT, 1152, C.w<bf16_t>(W_UQ), hd * 96 + (tb + 2) * 16, lane);
            if (latent && (wave & 1)) {
#pragma unroll
                for (int j = 0; j < 4; ++j) { const int p = pos0 + quad * 4 + j, pi = (r16 < 8) ? (p >> 6) : (p & 63), f = r16 & 7;
                    const float cs = rope[2048 + pi * 8 + f], sn = rope[2560 + pi * 8 + f]; const float x1 = a1[j], x2 = a2[j]; a1[j] = x1 * cs - x2 * sn; a2[j] = x1 * sn + x2 * cs; }
            }
#pragma unroll
            for (int j = 0; j < 4; ++j) { bf16_t* qp = qm + (size_t)(t0 + quad * 4 + j) * 384 + hd * 96 + tb * 16 + r16; qp[0] = f2bf(a0[j]); qp[16] = f2bf(a1[j]); qp[32] = f2bf(a2[j]); }
        }
        __syncthreads();
        if (tid < 64) { const int tk = tid >> 2, hd = tid & 3; C.w<float>(R_BS)[(size_t)(t0 + tk) * 4 + hd] = PART[tk * 16 + hd * 4] + PART[tk * 16 + hd * 4 + 1] + PART[tk * 16 + hd * 4 + 2] + PART[tk * 16 + hd * 4 + 3]; }
    }
    __syncthreads();
}
DI void phase_prep(const Ctx& C, int l) { for (int item = BIDX; item < 832; item += gridDim.x) prep_tile(C, l, item); }

constexpr int ST_FLOATS = 5 * 32 * 64 + 32 * 16;
DI void scan_fill(const Ctx& C, float* st, int d, int tb, int n, int h, int g, int c, int i) {
    const int step = i >> 3, part = i & 7; const int s = c * 32 + step; const int tok = d ? tb + n - 1 - s : tb + s;
    const bf16_t* zb = C.w<bf16_t>(WS_ZB) + (size_t)tok * ZBW; const size_t o = (size_t)tok * 256 + h * 64 + part * 8;
    const u32x4 rr = *(const u32x4*)(zb + h * 64 + part * 8);
    const f32x4 w0 = *(const f32x4*)(C.w<float>(d ? R_DEC1 : R_DEC0) + o), w1 = *(const f32x4*)(C.w<float>(d ? R_DEC1 : R_DEC0) + o + 4);
    const u32x4 kd = *(const u32x4*)(C.w<bf16_t>(d ? R_KD1 : R_KD0) + o), kk = *(const u32x4*)(C.w<bf16_t>(R_KK) + o), bb = *(const u32x4*)(C.w<bf16_t>(d ? R_B1 : R_B0) + o);
    u32x4 vv = {0u, 0u, 0u, 0u}; if (part < 2) vv = *(const u32x4*)(zb + 512 + h * 64 + g * 16 + part * 8);
    float* p = st + step * 64 + part * 8;
#define EXP8(dst, u) do { *(f32x4*)(dst) = (f32x4){__uint_as_float((u).x << 16), __uint_as_float((u).x & 0xffff0000u), __uint_as_float((u).y << 16), __uint_as_float((u).y & 0xffff0000u)}; \
        *(f32x4*)((dst) + 4) = (f32x4){__uint_as_float((u).z << 16), __uint_as_float((u).z & 0xffff0000u), __uint_as_float((u).w << 16), __uint_as_float((u).w & 0xffff0000u)}; } while (0)
    EXP8(p, rr); *(f32x4*)(p + 2048) = w0; *(f32x4*)(p + 2048 + 4) = w1; EXP8(p + 4096, kd); EXP8(p + 6144, kk); EXP8(p + 8192, bb);
    if (part < 2) { float* pv = st + 10240 + step * 16 + part * 8; EXP8(pv, vv); }
#undef EXP8
}
DI void scan_item(const Ctx& C, int l, int d, int seq, int h, int g) {
    const int tid = TIDX; const bool latent = seq >= 32;
    const int n = latent ? 2048 : 256, tb = latent ? TC + (seq - 32) * 2048 : seq * 256, nch = n / 32;
    float* buf = (float*)C.smem;
    const bool stager = tid >= 256; const int i = tid & 255, row = i >> 4, cgp = i & 15;
    f32x4 S = {0.f, 0.f, 0.f, 0.f};
    if (!stager && latent) S = *(const f32x4*)(C.in[3] + (((((size_t)(seq - 32) * 4 + l) * 2 + d) * 4 + h) * 64 + g * 16 + row) * 64 + cgp * 4);
    float* yout = C.w<float>(d ? R_Y1 : R_Y0) + h * 64 + g * 16 + row;
    if (stager) scan_fill(C, buf, d, tb, n, h, g, 0, i);
    __syncthreads();
    for (int c = 0; c < nch; ++c) {
        float* st = buf + (c & 1) * ST_FLOATS;
        if (stager) { if (c + 1 < nch) scan_fill(C, buf + ((c + 1) & 1) * ST_FLOATS, d, tb, n, h, g, c + 1, i); }
        else {
#pragma unroll 4
            for (int s = 0; s < 32; ++s) {
                const float* p = st + s * 64 + cgp * 4;
                const f32x4 r4 = *(const f32x4*)p, w4 = *(const f32x4*)(p + 2048), k4 = *(const f32x4*)(p + 4096), q4 = *(const f32x4*)(p + 6144), b4 = *(const f32x4*)(p + 8192);
                const float v = st[10240 + s * 16 + row];
                float sa = -(S[0] * q4[0] + S[1] * q4[1] + S[2] * q4[2] + S[3] * q4[3]); sa = rowsum16(sa);
                S = S * w4 + k4 * v + b4 * sa;
                float y = S[0] * r4[0] + S[1] * r4[1] + S[2] * r4[2] + S[3] * r4[3]; y = rowsum16(y);
                const int sg = c * 32 + s; const int tok = d ? tb + n - 1 - sg : tb + sg;
                if (cgp == 0) yout[(size_t)tok * 256] = y;
            }
        }
        __syncthreads();
    }
    if (!stager && !latent) *(f32x4*)(C.out + O_STATE + (((((size_t)seq * 4 + l) * 2 + d) * 4 + h) * 64 + g * 16 + row) * 64 + cgp * 4) = S;
}

template <int DK, bool NA>
DI void attn_wave(const bf16_t* Qp, int qs, const bf16_t* K0, const bf16_t* Vt0, int nblk0, int kstep0, const bf16_t* K1, const bf16_t* Vt1, int nblk1,
                  float scale, bf16_t* Op, const float* rb, int qr, int r0, int qc0, int cstart) {
    const int lane = TIDX & 63, r16 = lane & 15, quad = lane >> 4;
    bf16x8 qf[DK / 32];
#pragma unroll
    for (int ks = 0; ks < DK / 32; ++ks) qf[ks] = *(const bf16x8*)(Qp + (size_t)r16 * qs + ks * 32 + quad * 8);
    f32x4 o0 = {0.f, 0.f, 0.f, 0.f}, o1 = o0, o2 = o0, o3 = o0; float m = -1e30f, lsum = 0.f;
    const float sl2 = scale * 1.44269504f;
    const int nb = nblk0 + nblk1;
    for (int blk = 0; blk < nb; ++blk) {
        const bf16_t* Kb; const bf16_t* Vb;
        if (blk < nblk0) { Kb = K0 + (size_t)blk * kstep0 * DK; Vb = Vt0 + (size_t)blk * kstep0; } else { Kb = K1 + (size_t)(blk - nblk0) * 32 * DK; Vb = Vt1 + (size_t)(blk - nblk0) * 32; }
        f32x4 st0 = {0.f, 0.f, 0.f, 0.f}, st1 = st0;
        const bf16_t* kp = Kb + (size_t)r16 * DK + quad * 8;
#pragma unroll
        for (int ks = 0; ks < DK / 32; ++ks) { const bf16x8 a0 = *(const bf16x8*)(kp + ks * 32), a1 = *(const bf16x8*)(kp + 16 * DK + ks * 32);
            st0 = __builtin_amdgcn_mfma_f32_16x16x32_bf16(a0, qf[ks], st0, 0, 0, 0); st1 = __builtin_amdgcn_mfma_f32_16x16x32_bf16(a1, qf[ks], st1, 0, 0, 0); }
        const bf16_t* vp = Vb + (size_t)r16 * NKEY + quad * 4;
        const s16x4 v0l = *(const s16x4*)(vp), v0h = *(const s16x4*)(vp + 16);
        const s16x4 v1l = *(const s16x4*)(vp + (size_t)16 * NKEY), v1h = *(const s16x4*)(vp + (size_t)16 * NKEY + 16);
        const s16x4 v2l = *(const s16x4*)(vp + (size_t)32 * NKEY), v2h = *(const s16x4*)(vp + (size_t)32 * NKEY + 16);
        const s16x4 v3l = *(const s16x4*)(vp + (size_t)48 * NKEY), v3h = *(const s16x4*)(vp + (size_t)48 * NKEY + 16);
        float s[8];
#pragma unroll
        for (int j = 0; j < 4; ++j) { s[j] = st0[j] * sl2; s[4 + j] = st1[j] * sl2; }
        if (NA && blk < nblk0) {
            const int c = qc0 + r16; int c0 = c - 8; c0 = c0 < 0 ? 0 : (c0 > 48 ? 48 : c0); const int dr = r0 + blk - qr + 7;
#pragma unroll
            for (int j = 0; j < 8; ++j) { const int kc = cstart + (j >> 2) * 16 + quad * 4 + (j & 3); const bool ok = (kc >= c0) && (kc < c0 + 16);
                int dc = kc - c + 15; dc = dc < 0 ? 0 : (dc > 30 ? 30 : dc);
                s[j] = ok ? s[j] + rb[dr * 31 + dc] * 1.44269504f : -INFINITY; }
        }
        float mx = fmaxf(fmaxf(fmaxf(s[0], s[1]), fmaxf(s[2], s[3])), fmaxf(fmaxf(s[4], s[5]), fmaxf(s[6], s[7])));
        mx = fmaxf(mx, __shfl_xor(mx, 16)); mx = fmaxf(mx, __shfl_xor(mx, 32));
        const float mn = fmaxf(m, mx), alpha = __builtin_amdgcn_exp2f(m - mn); m = mn;
        float ps = 0.f;
#pragma unroll
        for (int j = 0; j < 8; ++j) { s[j] = __builtin_amdgcn_exp2f(s[j] - mn); ps += s[j]; }
        lsum = lsum * alpha + ps;
        o0 *= alpha; o1 *= alpha; o2 *= alpha; o3 *= alpha;
        u32x4 pw; pw.x = pg8::cvt_pk_bf16(s[0], s[1]); pw.y = pg8::cvt_pk_bf16(s[2], s[3]); pw.z = pg8::cvt_pk_bf16(s[4], s[5]); pw.w = pg8::cvt_pk_bf16(s[6], s[7]);
        const bf16x8 pf = __builtin_bit_cast(bf16x8, pw);
        o0 = __builtin_amdgcn_mfma_f32_16x16x32_bf16(__builtin_shufflevector(v0l, v0h, 0, 1, 2, 3, 4, 5, 6, 7), pf, o0, 0, 0, 0);
        o1 = __builtin_amdgcn_mfma_f32_16x16x32_bf16(__builtin_shufflevector(v1l, v1h, 0, 1, 2, 3, 4, 5, 6, 7), pf, o1, 0, 0, 0);
        o2 = __builtin_amdgcn_mfma_f32_16x16x32_bf16(__builtin_shufflevector(v2l, v2h, 0, 1, 2, 3, 4, 5, 6, 7), pf, o2, 0, 0, 0);
        o3 = __builtin_amdgcn_mfma_f32_16x16x32_bf16(__builtin_shufflevector(v3l, v3h, 0, 1, 2, 3, 4, 5, 6, 7), pf, o3, 0, 0, 0);
    }
    lsum += __shfl_xor(lsum, 16); lsum += __shfl_xor(lsum, 32);
    const float inv = 1.0f / lsum;
    bf16_t* op = Op + (size_t)r16 * 256 + quad * 4;
    { u32x2 w; w.x = pk2(o0[0] * inv, o0[1] * inv); w.y = pk2(o0[2] * inv, o0[3] * inv); *(u32x2*)(op) = w; }
    { u32x2 w; w.x = pk2(o1[0] * inv, o1[1] * inv); w.y = pk2(o1[2] * inv, o1[3] * inv); *(u32x2*)(op + 16) = w; }
    { u32x2 w; w.x = pk2(o2[0] * inv, o2[1] * inv); w.y = pk2(o2[2] * inv, o2[3] * inv); *(u32x2*)(op + 32) = w; }
    { u32x2 w; w.x = pk2(o3[0] * inv, o3[1] * inv); w.y = pk2(o3[2] * inv, o3[3] * inv); *(u32x2*)(op + 48) = w; }
}
DI void attn_item(const Ctx& C, int l, int kind, int seq, int hd, int qc) {
    const int wave = TIDX >> 6; const bool latent = seq >= 32;
    const int tb = latent ? TC + (seq - 32) * 2048 : seq * 256, koff = latent ? TC + (seq - 32) * 2560 : seq * 256;
    const int q0 = qc * 128 + wave * 16, tq = tb + q0;
    bf16_t* ys = C.w<bf16_t>(WS_HYS);
    const int nb = latent ? 80 : 8;
    if (kind == 0) {
        attn_wave<96, false>(C.w<bf16_t>(A_QM) + (size_t)tq * 384 + hd * 96, 384, C.w<bf16_t>(A_KM) + ((size_t)hd * NKEY + koff) * 96, C.w<bf16_t>(A_VTM) + (size_t)hd * 64 * NKEY + koff, nb, 32,
                             nullptr, nullptr, 0, 0.10206207261596575f, ys + ((size_t)1 * TT + tq) * 256 + hd * 64, nullptr, 0, 0, 0, 0);
    } else if (kind == 1) {
        const int kvh = hd >> 1;
        attn_wave<64, false>(C.w<bf16_t>(A_QG) + (size_t)tq * 256 + hd * 64, 256, C.w<bf16_t>(A_KG) + ((size_t)kvh * NKEY + koff) * 64, C.w<bf16_t>(A_VTG) + (size_t)kvh * 64 * NKEY + koff, nb, 32,
                             nullptr, nullptr, 0, 0.125f, ys + ((size_t)2 * TT + tq) * 256 + hd * 64, nullptr, 0, 0, 0, 0);
    } else {
        const bf16_t* Q = C.w<bf16_t>(WS_ZB) + (size_t)tq * ZBW + 2080 + hd * 64; const bf16_t* K = C.w<bf16_t>(A_KN) + ((size_t)hd * NKEY + koff) * 64; const bf16_t* Vt = C.w<bf16_t>(A_VTN) + (size_t)hd * 64 * NKEY + koff;
        bf16_t* O = ys + ((size_t)3 * TT + tq) * 256 + hd * 64;
        if (!latent) attn_wave<64, false>(Q, ZBW, K, Vt, 8, 32, nullptr, nullptr, 0, 0.125f, O, nullptr, 0, 0, 0, 0);
        else { const int qr = q0 >> 6, qcol = q0 & 63; int r0 = qr - 4; r0 = r0 < 0 ? 0 : (r0 > 24 ? 24 : r0); int cs = qcol - 8; cs = cs < 0 ? 0 : (cs > 32 ? 32 : cs);
            attn_wave<64, true>(Q, ZBW, K + (size_t)(r0 * 64 + cs) * 64, Vt + r0 * 64 + cs, 8, 64, K + (size_t)2048 * 64, Vt + 2048, 16, 0.125f, O,
                                C.in[34] + ((size_t)l * 4 + hd) * 15 * 31, qr, r0, qcol, cs); }
    }
}
constexpr int N_MIX = 2240;
DI void phase_mix(const Ctx& C, int l) {
    unsigned* ctr = C.w<unsigned>(WS_CTL) + 16 * l; volatile int* sitem = (volatile int*)(C.smem + LDS_MAIN);
    for (;;) {
        __syncthreads();
        if (TIDX == 0) *sitem = (int)atomicAdd(ctr, 1u);
        __syncthreads();
        const int item = *sitem;
        if (item >= N_MIX) break;
        if (item < 64) { const int chain = item >> 2; scan_item(C, l, chain >> 3, 32 + ((chain >> 2) & 1), chain & 3, item & 3); }
        else if (item < 320) { const int i = item - 64, r = i & 127; attn_item(C, l, i >> 7, 32 + (r >> 6), (r >> 4) & 3, r & 15); }
        else if (item < 448) { const int i = item - 320; attn_item(C, l, 2, 32 + (i >> 6), (i >> 4) & 3, i & 15); }
        else if (item < 1472) { const int i = item - 448, chain = i >> 2; scan_item(C, l, chain >> 7, (chain >> 2) & 31, chain & 3, i & 3); }
        else { const int i = item - 1472, r = i & 255; attn_item(C, l, i >> 8, r >> 3, (r >> 1) & 3, r & 1); }
    }
}
DI void phase_post(const Ctx& C, int l) {
    const int lane = TIDX & 63, wave = TIDX >> 6, col = lane * 4, hd = lane >> 4;
    const f32x4 lg = *(const f32x4*)(C.in[26] + l * 256 + col), lb = *(const f32x4*)(C.in[27] + l * 256 + col);
    for (int t = BIDX * 8 + wave; t < TT; t += gridDim.x * 8) {
        const size_t o = (size_t)t * 256 + col;
        f32x4 y = *(const f32x4*)(C.w<float>(R_Y0) + o) + *(const f32x4*)(C.w<float>(R_Y1) + o);
        const float mu = rowsum16(y[0] + y[1] + y[2] + y[3]) * (1.0f / 64.0f);
        const f32x4 dlt = y - mu; const float var = rowsum16(dlt[0] * dlt[0] + dlt[1] * dlt[1] + dlt[2] * dlt[2] + dlt[3] * dlt[3]) * (1.0f / 64.0f);
        const float rs = rsqrtf(var + 64e-5f);
        const u32x2 vw = *(const u32x2*)(C.w<bf16_t>(WS_ZB) + (size_t)t * ZBW + 512 + col), gw = *(const u32x2*)(C.w<bf16_t>(R_G) + o);
        const f32x4 v = {__uint_as_float(vw.x << 16), __uint_as_float(vw.x & 0xffff0000u), __uint_as_float(vw.y << 16), __uint_as_float(vw.y & 0xffff0000u)};
        const f32x4 g = {__uint_as_float(gw.x << 16), __uint_as_float(gw.x & 0xffff0000u), __uint_as_float(gw.y << 16), __uint_as_float(gw.y & 0xffff0000u)};
        const float bs = C.w<float>(R_BS)[(size_t)t * 4 + hd];
        const f32x4 r = (dlt * rs * lg + lb + v * bs) * g;
        u32x2 w; w.x = pk2(r[0], r[1]); w.y = pk2(r[2], r[3]);
        *(u32x2*)(C.w<bf16_t>(WS_HYS) + o) = w;
    }
}

constexpr int N_PHASES = 2 + NLAY * 10;
template <int PH> DI void run_phase(const Ctx& C, PG8_LAS unsigned char* lds) {
    if constexpr (PH == 0) { phase_mod(C); __syncthreads(); phase_convert(C, 0); }
    else if constexpr (PH == 1) phase_rowprep(C, 0, 0);
    else {
        constexpr int l = (PH - 2) / 10, s = (PH - 2) % 10;
        if constexpr (s == 0) { pg8::Gemm g{C.w<bf16_t>(WS_HYS), C.w<bf16_t>(W_IN), TT, NZ, DM, 1 << 20, 0}; pg8::StaticOrder S; S.init(TT, NZ, gridDim.x, BIDX);
            EpiZ E{C.w<bf16_t>(WS_ZB), C.w<bf16_t>(WS_GL)}; pg8::gemm_phase<EpiZ, pg8::StaticOrder>(lds, g, S, E, nullptr); }
        else if constexpr (s == 1) phase_prep(C, l);
        else if constexpr (s == 2) phase_mix(C, l);
        else if constexpr (s == 3) phase_post(C, l);
        else if constexpr (s == 4) { pg8::Gemm g{C.w<bf16_t>(WS_HYS), C.w<bf16_t>(W_BR), TT, 4096, 256, 4, (size_t)TT * 256 * 2}; pg8::StaticOrder S; S.init(TT, 4096, gridDim.x, BIDX);
            EpiGate E{C.w<bf16_t>(WS_GL), C.w<bf16_t>(WS_GP)}; pg8::gemm_phase<EpiGate, pg8::StaticOrder>(lds, g, S, E, nullptr); }
        else if constexpr (s == 5) { pg8::Gemm g{C.w<bf16_t>(WS_GP), C.w<bf16_t>(W_O4), TT, 1024, 4096, 1 << 20, 0}; pg8::StaticOrder S; S.init(TT, 1024, gridDim.x, BIDX);
            pg8::EpiF32 E{C.w<float>(WS_MO), 1024, nullptr}; pg8::gemm_phase<pg8::EpiF32, pg8::StaticOrder>(lds, g, S, E, nullptr); }
        else if constexpr (s == 6) phase_rowprep(C, 1, l);
        else if constexpr (s == 7) { pg8::Gemm g{C.w<bf16_t>(WS_HYS), C.w<bf16_t>(W_GU), TT, 5632, DM, 1 << 20, 0}; pg8::StaticOrder S; S.init(TT, 5632, gridDim.x, BIDX);
            EpiSwiGLU E{C.w<bf16_t>(WS_GL)}; pg8::gemm_phase<EpiSwiGLU, pg8::StaticOrder>(lds, g, S, E, nullptr); }
        else if constexpr (s == 8) { pg8::Gemm g{C.w<bf16_t>(WS_GL), C.w<bf16_t>(W_DN), TT, 1024, FF, 1 << 20, 0}; pg8::StaticOrder S; S.init(TT, 1024, gridDim.x, BIDX);
            pg8::EpiF32 E{C.w<float>(WS_MO), 1024, nullptr}; pg8::gemm_phase<pg8::EpiF32, pg8::StaticOrder>(lds, g, S, E, nullptr); }
        else { phase_rowprep(C, 2, l); if constexpr (l + 1 < NLAY) { __syncthreads(); phase_convert(C, l + 1); } }
    }
}
template <int PH> DI void run_all(const Params& P, unsigned char* smem, cg::grid_group& grid) {
    if constexpr (PH < N_PHASES) {
#ifdef ONLY_S
        if constexpr (PH >= 2 && (PH - 2) % 10 == ONLY_S)
#endif
        if (P.ph_lo <= PH && PH < P.ph_hi) {
            Ctx C; { unsigned char* w_ = P.ws; float* o_ = P.out; KIn i_ = (KIn)__builtin_amdgcn_kernarg_segment_ptr(); asm volatile("" : "+s"(w_), "+s"(o_), "+s"(i_)); C.ws = w_; C.out = o_; C.in = i_; C.smem = smem; }
            run_phase<PH>(C, (PG8_LAS unsigned char*)smem);
            if (PH + 1 < P.ph_hi) grid.sync();
        }
        run_all<PH + 1>(P, smem, grid);
    }
}
__global__ void __launch_bounds__(NTHR) mega(Params P) {
    extern __shared__ __attribute__((aligned(16))) unsigned char smem[];
    cg::grid_group grid = cg::this_grid();
    run_all<0>(P, smem, grid);
}

extern "C" void kernel_launch(void* const* d_in, const int* in_sizes, int n_in, void* d_out, int out_size, void* d_ws, size_t ws_size, hipStream_t stream) {
    static int grid_blocks = 0;
    if (grid_blocks == 0) {
        int dev = 0, cus = 0, per_cu = 0;
        hipGetDevice(&dev); hipDeviceGetAttribute(&cus, hipDeviceAttributeMultiprocessorCount, dev);
        if (hipFuncSetAttribute((const void*)mega, hipFuncAttributeMaxDynamicSharedMemorySize, LDS_BYTES) != hipSuccess) { fprintf(stderr, "hipFuncSetAttribute failed\n"); grid_blocks = -1; return; }
        hipOccupancyMaxActiveBlocksPerMultiprocessor(&per_cu, (const void*)mega, NTHR, LDS_BYTES);
        if (per_cu < 1) per_cu = 1;
        grid_blocks = cus * (per_cu > 1 ? 1 : per_cu);
        if (n_in != 40 || ws_size < WS_END) { fprintf(stderr, "kernel_launch: unexpected n_in %d or workspace %zu < %zu\n", n_in, ws_size, (size_t)WS_END); grid_blocks = -1; return; }
    }
    if (grid_blocks < 0) return;
    hipMemsetAsync((char*)d_ws + WS_CTL, 0, 4096, stream);
    Params P{};
    for (int i = 0; i < 40; ++i) P.in[i] = (const float*)d_in[i];
    P.out = (float*)d_out; P.ws = (unsigned char*)d_ws; P.ph_lo = 0; P.ph_hi = N_PHASES;
    void* args[] = {&P};
    hipError_t e = hipLaunchCooperativeKernel((const void*)mega, dim3(grid_blocks), dim3(NTHR), args, LDS_BYTES, stream);
    if (e != hipSuccess) fprintf(stderr, "cooperative launch failed: %s (grid %d)\n", hipGetErrorString(e), grid_blocks);
}
```

```cpp
#include <hip/hip_runtime.h>
#include <hip/hip_cooperative_groups.h>
#include <cstdio>
namespace cg = cooperative_groups;

__device__ __forceinline__ int ltid() { int t = (int)threadIdx.x; asm volatile("" : "+v"(t)); return t; }
__device__ __forceinline__ int lbid() { int t = (int)blockIdx.x; asm volatile("" : "+s"(t)); return t; }
#define TIDX ltid()
#define BIDX lbid()

namespace pg8 {
#define PG8_LAS __attribute__((address_space(3)))
typedef unsigned short bf16_t;
typedef short bf16x8 __attribute__((ext_vector_type(8)));
typedef float f32x4 __attribute__((ext_vector_type(4)));
typedef unsigned u32x4 __attribute__((ext_vector_type(4)));
constexpr int BM = 256, BK = 64, HALF = 128, HTB = HALF * BK * 2  , STAGE_BYTES = 8 * HTB, NXCD = 8, WGM = 8;

__host__ __device__ __forceinline__ int lds_byte(int r, int c) { const int st = (r >> 4) * 2 + (c >> 5), rr = r & 15, cc = c & 31, ob = rr * 64 + cc * 2; return st * 1024 + (ob ^ (((ob >> 9) & 1) << 5)); }
__host__ __device__ __forceinline__ void stage_rc(int b, int& R, int& C) { const int st = b / 1024, sb = b % 1024, swz = sb ^ (((sb >> 9) & 1) << 5); R = (st >> 1) * 16 + swz / 64; C = (st & 1) * 32 + (swz % 64) / 2; }
__host__ __device__ __forceinline__ int perm32(int rho) { const int n = rho >> 4, i = rho & 15; return 8 * (i >> 2) + 4 * n + (i & 3); }

struct Unit { int pm, pn; };
struct Gemm { const bf16_t* A; const bf16_t* Bt; int M, N, K; int ppg; size_t ags; };

struct StaticOrder {
    int nM, nN, nwg, G, c;
    __host__ __device__ void init(int M, int N, int G_, int c_) { nM = M / BM; nN = N / BM; nwg = nM * nN; G = G_; c = c_; }
    __host__ __device__ bool next(int i, Unit& u) const {
        const long L = (long)i * G + c; if (L >= nwg) return false;
        int wgid = (int)L; { const int q = nwg / NXCD, r = nwg % NXCD, xcd = wgid % NXCD, off = wgid / NXCD; wgid = (xcd < r ? xcd * (q + 1) : r * (q + 1) + (xcd - r) * q) + off; }
        const int nig = WGM * nN, gid = wgid / nig, fm = gid * WGM, gsz = (nM - fm) < WGM ? (nM - fm) : WGM;
        u.pm = fm + ((wgid % nig) % gsz); u.pn = (wgid % nig) / gsz; return true;
    }
    __device__ __forceinline__ void a_ready(const Unit&) const {}
    __device__ __forceinline__ void done(const Unit&) const {}
};
__device__ __forceinline__ unsigned cvt_pk_bf16(float lo, float hi) { unsigned r; asm volatile("v_cvt_pk_bf16_f32 %0, %1, %2" : "=v"(r) : "v"(lo), "v"(hi)); return r; }
typedef float f32x2 __attribute__((ext_vector_type(2)));
struct EpiF32 {
    static constexpr bool PERM = false, AFTER_DRAIN = false;
    float* C; int ldc; const float* bias;
    __device__ __forceinline__ void operator()(const f32x4 (&acc)[2][2][4][2], const Unit& u, int wr, int wc, int fr, int fq) const {
        const int row0 = u.pm * BM + wr * 64 + fr, col0 = u.pn * BM + wc * 32 + 4 * fq;
        f32x4 bv[2][2];
#pragma unroll
        for (int bj = 0; bj < 2; ++bj)
#pragma unroll
            for (int n = 0; n < 2; ++n) bv[bj][n] = bias ? *(const f32x4*)(bias + col0 + bj * HALF + n * 16) : (f32x4){0.f, 0.f, 0.f, 0.f};
#pragma unroll
        for (int ai = 0; ai < 2; ++ai)
#pragma unroll
            for (int m = 0; m < 4; ++m) { float* rowp = C + (size_t)(row0 + ai * HALF + m * 16) * ldc + col0;
#pragma unroll
                for (int bj = 0; bj < 2; ++bj)
#pragma unroll
                    for (int n = 0; n < 2; ++n) *(f32x4*)(rowp + bj * HALF + n * 16) = acc[ai][bj][m][n] + bv[bj][n]; }
    }
};
template <class Epi, class Sched, bool STAMP = false>
__device__ __forceinline__ void gemm_phase(PG8_LAS unsigned char* lds, const Gemm g, const Sched& S, const Epi& E, unsigned long long* stamps) {
    const int tid = TIDX, wid = __builtin_amdgcn_readfirstlane(tid >> 6), lane = tid & 63, wr = wid >> 2, wc = wid & 3, fr = lane & 15, fq = lane >> 4;
    const int K = g.K, nt = K / BK;
    int ts_lo = 0, ts_hi = 0, nts = 0;
#define PG8_STAMP() do { if (STAMP && wid == 0 && nts < 64) { const unsigned long long _c = (unsigned long long)clock64(); \
        ts_lo = (lane == nts) ? (int)(unsigned)_c : ts_lo; ts_hi = (lane == nts) ? (int)(unsigned)(_c >> 32) : ts_hi; ++nts; } } while (0)
    PG8_STAMP();
    unsigned voffA[2], voffB[2];
#pragma unroll
    for (int i = 0; i < 2; ++i) { int R, C; stage_rc(tid * 16 + i * 8192, R, C); const int Rb = Epi::PERM ? ((R & ~31) + perm32(R & 31)) : R;
        voffA[i] = (unsigned)(R * K + C) * 2u; voffB[i] = (unsigned)(Rb * K + C) * 2u; }
    const size_t kstep = (size_t)(BK * 2);
    const size_t hstep = (size_t)HALF * K * 2;
    const size_t tstep = 2 * hstep;
    const unsigned ldsw = (unsigned)wid * 1024u;
    const int aoff = lds_byte(wr * 64 + fr, fq * 8), boff = lds_byte(wc * 32 + fr, fq * 8);
#define PG8_SA(b, h) (((b) * 2 + (h)) * HTB)
#define PG8_SB(b, h) ((4 + (b) * 2 + (h)) * HTB)
#define PG8_STAGE(bufoff, gbase, voff) do { _Pragma("unroll") for (int _i = 0; _i < 2; ++_i) \
        __builtin_amdgcn_global_load_lds((const unsigned*)((const char*)(gbase) + (voff)[_i]), (PG8_LAS unsigned*)(lds + (bufoff) + ldsw + _i * 8192), 16, 0, 0); } while (0)
#define PG8_LDA(dst, b, h) do { _Pragma("unroll") for (int m = 0; m < 4; ++m) _Pragma("unroll") for (int k = 0; k < 2; ++k) dst[m][k] = *(const PG8_LAS bf16x8*)(lds + PG8_SA(b, h) + aoff + m * 2048 + k * 1024); } while (0)
#define PG8_LDB(dst, b, h) do { _Pragma("unroll") for (int n = 0; n < 2; ++n) _Pragma("unroll") for (int k = 0; k < 2; ++k) dst[n][k] = *(const PG8_LAS bf16x8*)(lds + PG8_SB(b, h) + boff + n * 2048 + k * 1024); } while (0)
#define PG8_MMA(ai, bj, At, Bt) do { __builtin_amdgcn_s_setprio(1); _Pragma("unroll") for (int m = 0; m < 4; ++m) _Pragma("unroll") for (int n = 0; n < 2; ++n) _Pragma("unroll") for (int k = 0; k < 2; ++k) \
        acc[ai][bj][m][n] = __builtin_amdgcn_mfma_f32_16x16x32_bf16(Bt[n][k], At[m][k], acc[ai][bj][m][n], 0, 0, 0); __builtin_amdgcn_s_setprio(0); } while (0)
#define PG8_WAIT_V(n) asm volatile("s_waitcnt vmcnt(" #n ")" ::: "memory")
#define PG8_WAIT_L(n) asm volatile("s_waitcnt lgkmcnt(" #n ")" ::: "memory")
#define PG8_BAR __builtin_amdgcn_s_barrier()
#define PG8_SCHED __builtin_amdgcn_sched_barrier(0)
    Unit cur, nxt; int ui = 0;
    if (!S.next(0, cur)) return;
    f32x4 acc[2][2][4][2];
#pragma unroll
    for (int a = 0; a < 2; ++a)
#pragma unroll
        for (int b = 0; b < 2; ++b)
#pragma unroll
            for (int m = 0; m < 4; ++m)
#pragma unroll
                for (int n = 0; n < 2; ++n) acc[a][b][m][n] = (f32x4){0.f, 0.f, 0.f, 0.f};
    bf16x8 At[4][2], B0[2][2], B1[2][2];
    const char* cA = (const char*)g.A + (size_t)cur.pm * tstep + (size_t)(cur.pn / g.ppg) * g.ags; const char* cB = (const char*)g.Bt + (size_t)cur.pn * tstep;
    S.a_ready(cur);
    PG8_STAGE(PG8_SB(0, 0), cB, voffB); PG8_STAGE(PG8_SA(0, 0), cA, voffA); PG8_STAGE(PG8_SB(0, 1), cB + hstep, voffB); PG8_STAGE(PG8_SA(0, 1), cA + hstep, voffA);
    if (wr == 1) PG8_BAR;
    PG8_WAIT_V(4); PG8_BAR;
    PG8_STAGE(PG8_SB(1, 0), cB + kstep, voffB); PG8_STAGE(PG8_SA(1, 0), cA + kstep, voffA); PG8_STAGE(PG8_SB(1, 1), cB + hstep + kstep, voffB);
    PG8_WAIT_V(6); PG8_BAR;
    PG8_STAMP();
    for (;;) {
        const bool has_next = S.next(ui + 1, nxt);
        const char* nA = has_next ? (const char*)g.A + (size_t)nxt.pm * tstep + (size_t)(nxt.pn / g.ppg) * g.ags : cA; const char* nB = has_next ? (const char*)g.Bt + (size_t)nxt.pn * tstep : cB;
#pragma unroll 1
        for (int t = 0; t < nt; t += 2) {
            const bool last = (t == nt - 2);
            const char* a1 = cA + (size_t)(t + 1) * kstep;
            const char* a2 = last ? nA : cA + (size_t)(t + 2) * kstep; const char* b2 = last ? nB : cB + (size_t)(t + 2) * kstep;
            const char* a3 = a2 + kstep; const char* b3 = b2 + kstep;
            if (last && has_next) S.a_ready(nxt);
            PG8_LDB(B0, 0, 0); PG8_SCHED; PG8_LDA(At, 0, 0); PG8_STAGE(PG8_SA(1, 1), a1 + hstep, voffA);
            PG8_WAIT_L(8); PG8_BAR; PG8_WAIT_L(0); PG8_MMA(0, 0, At, B0); PG8_BAR; PG8_SCHED;
            PG8_LDB(B1, 0, 1); PG8_STAGE(PG8_SB(0, 0), b2, voffB);
            PG8_BAR; PG8_WAIT_L(0); PG8_MMA(0, 1, At, B1); PG8_BAR;
            PG8_LDA(At, 0, 1); PG8_STAGE(PG8_SA(0, 0), a2, voffA);
            PG8_BAR; PG8_WAIT_L(0); PG8_MMA(1, 0, At, B0); PG8_BAR; PG8_SCHED;
            PG8_STAGE(PG8_SB(0, 1), b2 + hstep, voffB);
            PG8_WAIT_V(6); PG8_BAR; PG8_MMA(1, 1, At, B1); PG8_BAR;
            PG8_LDB(B0, 1, 0); PG8_SCHED; PG8_LDA(At, 1, 0); PG8_STAGE(PG8_SA(0, 1), a2 + hstep, voffA);
            PG8_WAIT_L(8); PG8_BAR; PG8_WAIT_L(0); PG8_MMA(0, 0, At, B0); PG8_BAR; PG8_SCHED;
            PG8_LDB(B1, 1, 1); PG8_STAGE(PG8_SB(1, 0), b3, voffB);
            PG8_BAR; PG8_WAIT_L(0); PG8_MMA(0, 1, At, B1); PG8_BAR;
            PG8_LDA(At, 1, 1); PG8_STAGE(PG8_SA(1, 0), a3, voffA);
            PG8_BAR; PG8_WAIT_L(0); PG8_MMA(1, 0, At, B0); PG8_BAR; PG8_SCHED;
            PG8_STAGE(PG8_SB(1, 1), b3 + hstep, voffB);
            PG8_WAIT_V(6); PG8_BAR; PG8_MMA(1, 1, At, B1); PG8_BAR;
        }
        PG8_STAMP();
        if constexpr (!Epi::AFTER_DRAIN) { E(acc, cur, wr, wc, fr, fq); S.done(cur); }
        PG8_STAMP();
        if (!has_next) break;
#pragma unroll
        for (int a = 0; a < 2; ++a)
#pragma unroll
            for (int b = 0; b < 2; ++b)
#pragma unroll
                for (int m = 0; m < 4; ++m)
#pragma unroll
                    for (int n = 0; n < 2; ++n) acc[a][b][m][n] = (f32x4){0.f, 0.f, 0.f, 0.f};
        cur = nxt; cA = nA; cB = nB; ++ui;
    }
    PG8_WAIT_V(0);
    if (wr == 0) PG8_BAR;
    PG8_BAR;
    if constexpr (Epi::AFTER_DRAIN) { E.fused(acc, cur, wr, wc, fr, fq, lds, wid, lane); S.done(cur); }
    PG8_STAMP();
    if (STAMP && wid == 0) { stamps[lane] = lane < nts ? (((unsigned long long)(unsigned)ts_hi << 32) | (unsigned)ts_lo) : 0ull;
        }
#undef PG8_STAMP
#undef PG8_SA
#undef PG8_SB
#undef PG8_STAGE
#undef PG8_LDA
#undef PG8_LDB
#undef PG8_MMA
#undef PG8_WAIT_V
#undef PG8_WAIT_L
#undef PG8_BAR
#undef PG8_SCHED
}
}

using pg8::bf16_t; using pg8::bf16x8; using pg8::f32x4; using pg8::u32x4;
typedef short s16x4 __attribute__((ext_vector_type(4)));
typedef unsigned u32x2 __attribute__((ext_vector_type(2)));
#define DI __device__ __forceinline__

constexpr int TC = 8192, TLAT = 4096, TT = 12288, DM = 1024, NLAY = 4;
constexpr int NIN = 6944, NZ = 7168, ZBW = 3072, GLW = 4096, FF = 2816;
constexpr int NKEY = 13312;
constexpr int NTHR = 512;
constexpr int LDS_MAIN = 131072, LDS_BYTES = LDS_MAIN + 1024;

constexpr size_t al256(size_t x) { return (x + 255) & ~(size_t)255; }
constexpr size_t WS_CTL = 0;
constexpr size_t WS_MOD = 4096;
constexpr size_t WS_ROPE = WS_MOD + al256((size_t)4 * 3 * 6144 * 4);
constexpr size_t WS_W = WS_ROPE + al256((size_t)(1024 * 2 + 512 * 2) * 4);
constexpr size_t W_IN = WS_W;
constexpr size_t W_BR = W_IN + (size_t)NZ * DM * 2;
constexpr size_t W_O4 = W_BR + (size_t)4096 * 256 * 2;
constexpr size_t W_GU = W_O4 + (size_t)1024 * 4096 * 2;
constexpr size_t W_DN = W_GU + (size_t)5632 * 1024 * 2;
constexpr size_t W_UQ = W_DN + (size_t)1024 * FF * 2;
constexpr size_t W_UKV = W_UQ + (size_t)384 * 256 * 2;
constexpr size_t W_W2 = W_UKV + (size_t)512 * 128 * 2;
constexpr size_t W_A2 = W_W2 + (size_t)2 * 256 * 64 * 2;
constexpr size_t W_G2 = W_A2 + (size_t)2 * 256 * 64 * 2;
constexpr size_t WS_HYS = al256(W_G2 + (size_t)256 * 128 * 2);
constexpr size_t WS_ZB = WS_HYS + (size_t)TT * DM * 2;
constexpr size_t WS_GL = WS_ZB + (size_t)TT * ZBW * 2;
constexpr size_t WS_GP = WS_GL + (size_t)TT * GLW * 2;
constexpr size_t WS_MO = WS_GP + (size_t)TT * GLW * 2;
constexpr size_t WS_END = WS_MO + (size_t)TT * DM * 4;
constexpr size_t SZ_B = (size_t)TT * 256 * 2, SZ_F = (size_t)TT * 256 * 4;
constexpr size_t R_KK = WS_GP, R_KD0 = R_KK + SZ_B, R_KD1 = R_KD0 + SZ_B, R_B0 = R_KD1 + SZ_B, R_B1 = R_B0 + SZ_B;
constexpr size_t R_DEC0 = R_B1 + SZ_B, R_DEC1 = R_DEC0 + SZ_F, R_G = R_DEC1 + SZ_F, R_BS = R_G + SZ_B;
constexpr size_t R_Y0 = R_BS + al256((size_t)TT * 4 * 4), R_Y1 = R_Y0 + SZ_F;
constexpr size_t A_QM = R_Y1 + SZ_F;
constexpr size_t A_KM = A_QM + (size_t)TT * 384 * 2;
constexpr size_t A_VTM = A_KM + (size_t)4 * NKEY * 96 * 2;
constexpr size_t A_QG = A_VTM + (size_t)256 * NKEY * 2;
constexpr size_t A_KG = A_QG + (size_t)TT * 256 * 2;
constexpr size_t A_VTG = A_KG + (size_t)2 * NKEY * 64 * 2;
constexpr size_t A_KN = A_VTG + (size_t)128 * NKEY * 2;
constexpr size_t A_VTN = A_KN + (size_t)4 * NKEY * 64 * 2;
constexpr size_t A_END = A_VTN + (size_t)256 * NKEY * 2;
static_assert(A_END <= WS_END, "branch scratch overflows");

constexpr size_t O_X = 0, O_STATE = 12582912, O_CKV = 16777216, O_KPE = 20971520, O_GK = 22020096, O_GV = 26214400, O_NK = 30408704, O_NV = 38797312;

struct Params { const float* in[40]; float* out; unsigned char* ws; int ph_lo, ph_hi; };

DI float bf2f(bf16_t b) { return __uint_as_float(((unsigned)b) << 16); }
DI bf16_t f2bf(float f) { unsigned u = __float_as_uint(f); u += 0x7FFFu + ((u >> 16) & 1u); return (bf16_t)(u >> 16); }
DI unsigned pk2(float lo, float hi) { return (unsigned)f2bf(lo) | ((unsigned)f2bf(hi) << 16); }
DI float sigmoidf_(float x) { return __builtin_amdgcn_rcpf(1.0f + __expf(-x)); }
template <int CTRL> DI float dppf(float x) { return __int_as_float(__builtin_amdgcn_update_dpp(0, __float_as_int(x), CTRL, 0xf, 0xf, true)); }
DI float rowsum16(float x) { x += dppf<0x128>(x); x += dppf<0x124>(x); x += dppf<0x122>(x); x += dppf<0x121>(x); return x; }
DI float wavesum(float x) { for (int o = 32; o >= 1; o >>= 1) x += __shfl_xor(x, o); return x; }

struct EpiZ {
    static constexpr bool PERM = true, AFTER_DRAIN = false;
    bf16_t* zb; bf16_t* gl;
    DI void operator()(const f32x4 (&acc)[2][2][4][2], const pg8::Unit& u, int wr, int wc, int fr, int fq) const {
        const int row0 = u.pm * 256 + wr * 64 + fr; bf16_t* base; int ldc, colt;
        if (u.pn < 12) { base = zb; ldc = ZBW; colt = u.pn * 256; } else { base = gl; ldc = GLW; colt = (u.pn - 12) * 256; }
        const int col0 = colt + wc * 32 + 8 * fq;
#pragma unroll
        for (int ai = 0; ai < 2; ++ai)
#pragma unroll
            for (int m = 0; m < 4; ++m) { bf16_t* rowp = base + (size_t)(row0 + ai * 128 + m * 16) * ldc + col0;
#pragma unroll
                for (int bj = 0; bj < 2; ++bj) { const f32x4 v0 = acc[ai][bj][m][0], v1 = acc[ai][bj][m][1];
                    u32x4 w; w.x = pg8::cvt_pk_bf16(v0[0], v0[1]); w.y = pg8::cvt_pk_bf16(v0[2], v0[3]); w.z = pg8::cvt_pk_bf16(v1[0], v1[1]); w.w = pg8::cvt_pk_bf16(v1[2], v1[3]);
                    *(u32x4*)(rowp + bj * 128) = w; } }
    }
};
struct EpiGate {
    static constexpr bool PERM = true, AFTER_DRAIN = false;
    const bf16_t* gl; bf16_t* gp;
    DI void operator()(const f32x4 (&acc)[2][2][4][2], const pg8::Unit& u, int wr, int wc, int fr, int fq) const {
        const int row0 = u.pm * 256 + wr * 64 + fr; const int col0 = u.pn * 256 + wc * 32 + 8 * fq;
#pragma unroll
        for (int ai = 0; ai < 2; ++ai)
#pragma unroll
            for (int m = 0; m < 4; ++m) {
#pragma unroll
                for (int bj = 0; bj < 2; ++bj) { const size_t off = (size_t)(row0 + ai * 128 + m * 16) * GLW + col0 + bj * 128;
                    const u32x4 gw = *(const u32x4*)(gl + off); u32x4 w;
                    { const f32x4 v = acc[ai][bj][m][0];
                      w.x = pg8::cvt_pk_bf16(v[0] * sigmoidf_(__uint_as_float(gw.x << 16)), v[1] * sigmoidf_(__uint_as_float(gw.x & 0xffff0000u)));
                      w.y = pg8::cvt_pk_bf16(v[2] * sigmoidf_(__uint_as_float(gw.y << 16)), v[3] * sigmoidf_(__uint_as_float(gw.y & 0xffff0000u))); }
                    { const f32x4 v = acc[ai][bj][m][1];
                      w.z = pg8::cvt_pk_bf16(v[0] * sigmoidf_(__uint_as_float(gw.z << 16)), v[1] * sigmoidf_(__uint_as_float(gw.z & 0xffff0000u)));
                      w.w = pg8::cvt_pk_bf16(v[2] * sigmoidf_(__uint_as_float(gw.w << 16)), v[3] * sigmoidf_(__uint_as_float(gw.w & 0xffff0000u))); }
                    *(u32x4*)(gp + off) = w;
                    asm volatile("" ::: "memory"); } }
    }
};
struct EpiSwiGLU {
    static constexpr bool PERM = false, AFTER_DRAIN = false;
    bf16_t* act;
    DI void operator()(const f32x4 (&acc)[2][2][4][2], const pg8::Unit& u, int wr, int wc, int fr, int fq) const {
        const int row0 = u.pm * 256 + wr * 64 + fr; const int col0 = (u.pn * 256 + wc * 32) / 2 + 4 * fq;
#pragma unroll
        for (int ai = 0; ai < 2; ++ai)
#pragma unroll
            for (int m = 0; m < 4; ++m) { bf16_t* rowp = act + (size_t)(row0 + ai * 128 + m * 16) * FF + col0;
#pragma unroll
                for (int bj = 0; bj < 2; ++bj) { const f32x4 g = acc[ai][bj][m][0], up = acc[ai][bj][m][1];
                    u32x2 w; w.x = pg8::cvt_pk_bf16(g[0] * sigmoidf_(g[0]) * up[0], g[1] * sigmoidf_(g[1]) * up[1]);
                    w.y = pg8::cvt_pk_bf16(g[2] * sigmoidf_(g[2]) * up[2], g[3] * sigmoidf_(g[3]) * up[3]);
                    *(u32x2*)(rowp + bj * 64) = w; } }
    }
};

typedef const float* cfp_t;
typedef const cfp_t __attribute__((address_space(4)))* KIn;
struct Ctx {
    KIn in; float* out; unsigned char* ws; unsigned char* smem; int rep = 0;
    template <class T> DI T* w(size_t off) const { return (T*)(ws + off); }
};

DI void phase_mod(const Ctx& C) {
    const int tid = TIDX;
    float* sc = (float*)C.smem;
    float* red = sc + 3072;
    for (int i = tid; i < 3072; i += NTHR) { const int j = i >> 10, k = i & 1023; const float v = (j == 0) ? C.in[10][k] : C.in[2][(j - 1) * 1024 + k]; sc[i] = v * sigmoidf_(v); }
    __syncthreads();
    float* mod = C.w<float>(WS_MOD);
    for (int item = BIDX; item < 4 * 48; item += gridDim.x) {
        const int l = item / 48, cb = item % 48, col = cb * 128 + (tid & 127), kg = tid >> 7;
        const float* wp = C.in[11] + ((size_t)l * 1024 + kg * 256) * 6144 + col;
        float a0 = 0.f, a1 = 0.f, a2 = 0.f;
#pragma unroll 8
        for (int k = 0; k < 256; ++k) { const float w = wp[(size_t)k * 6144]; a0 += sc[kg * 256 + k] * w; a1 += sc[1024 + kg * 256 + k] * w; a2 += sc[2048 + kg * 256 + k] * w; }
        red[(kg * 3 + 0) * 128 + (tid & 127)] = a0; red[(kg * 3 + 1) * 128 + (tid & 127)] = a1; red[(kg * 3 + 2) * 128 + (tid & 127)] = a2;
        __syncthreads();
        if (tid < 384) { const int j = tid >> 7, c = tid & 127; const float s = red[(0 * 3 + j) * 128 + c] + red[(1 * 3 + j) * 128 + c] + red[(2 * 3 + j) * 128 + c] + red[(3 * 3 + j) * 128 + c];
            mod[((size_t)l * 3 + j) * 6144 + cb * 128 + c] = s + C.in[12][l * 6144 + cb * 128 + c]; }
        __syncthreads();
    }
    if (BIDX == gridDim.x - 1) {
        float* rp = C.w<float>(WS_ROPE);
        for (int i = tid; i < 1024; i += NTHR) { const int p = i >> 4, f = i & 15; const float inv = powf(10000.0f, -(float)f / 16.0f); const float a = (float)p * inv; rp[i] = cosf(a); rp[1024 + i] = sinf(a); }
        for (int i = tid; i < 512; i += NTHR) { const int p = i >> 3, f = i & 7; const float inv = powf(10000.0f, -(float)f / 8.0f); const float a = (float)p * inv; rp[2048 + i] = cosf(a); rp[2560 + i] = sinf(a); }
    }
}

DI void conv_job(const Ctx& C, const float* src, bf16_t* dst, int K, int N, int ld, int mode) {
    float* tile = (float*)C.smem;
    const int tid = TIDX, nk = K / 64, nn = (N + 63) / 64;
    for (int t = BIDX; t < nk * nn; t += gridDim.x) {
        const int k0 = (t % nk) * 64, n0 = (t / nk) * 64;
#pragma unroll
        for (int i = 0; i < 2; ++i) { const int k = (tid >> 4) + 32 * i, n4 = (tid & 15) * 4;
            f32x4 v = {0.f, 0.f, 0.f, 0.f}; if (n0 + n4 < N) v = *(const f32x4*)(src + (size_t)(k0 + k) * N + n0 + n4);
            tile[k * 65 + n4] = v[0]; tile[k * 65 + n4 + 1] = v[1]; tile[k * 65 + n4 + 2] = v[2]; tile[k * 65 + n4 + 3] = v[3]; }
        __syncthreads();
        { const int n = tid >> 3, k8 = (tid & 7) * 8, ng = n0 + n;
          if (ng < N) {
            u32x4 w; w.x = pk2(tile[(k8 + 0) * 65 + n], tile[(k8 + 1) * 65 + n]); w.y = pk2(tile[(k8 + 2) * 65 + n], tile[(k8 + 3) * 65 + n]);
            w.z = pk2(tile[(k8 + 4) * 65 + n], tile[(k8 + 5) * 65 + n]); w.w = pk2(tile[(k8 + 6) * 65 + n], tile[(k8 + 7) * 65 + n]);
            int row = ng;
            if (mode == 1) row = ng < 2848 ? ng : ng + 224;
            else if (mode == 3) row = (ng >> 4) * 32 + (ng & 15);
            else if (mode == 4) row = (ng >> 4) * 32 + 16 + (ng & 15);
            bf16_t* dp = dst + (size_t)row * ld + k0 + k8;
            *(u32x4*)dp = w;
            if (mode == 2) { *(u32x4*)(dp + 1024) = w; *(u32x4*)(dp + 2048) = w; *(u32x4*)(dp + 3072) = w; }
          } }
        __syncthreads();
    }
}
DI void phase_convert(const Ctx& C, int l) {
    { bf16_t* z = C.w<bf16_t>(W_IN) + (size_t)2848 * 1024;
      for (int i = BIDX * NTHR + TIDX; i < 224 * 1024 / 8; i += gridDim.x * NTHR) *(u32x4*)(z + (size_t)i * 8) = (u32x4){0u, 0u, 0u, 0u}; }
    conv_job(C, C.in[17] + (size_t)l * 1024 * NIN, C.w<bf16_t>(W_IN), 1024, NIN, 1024, 1);
    for (int n = 0; n < 4; ++n) conv_job(C, C.in[35] + ((size_t)l * 4 + n) * 256 * 1024, C.w<bf16_t>(W_BR) + (size_t)n * 1024 * 256, 256, 1024, 256, 0);
    conv_job(C, C.in[36] + (size_t)l * 1024 * 1024, C.w<bf16_t>(W_O4), 1024, 1024, 4096, 2);
    conv_job(C, C.in[37] + (size_t)l * 1024 * FF, C.w<bf16_t>(W_GU), 1024, FF, 1024, 3);
    conv_job(C, C.in[38] + (size_t)l * 1024 * FF, C.w<bf16_t>(W_GU), 1024, FF, 1024, 4);
    conv_job(C, C.in[39] + (size_t)l * FF * 1024, C.w<bf16_t>(W_DN), FF, 1024, FF, 0);
    conv_job(C, C.in[29] + (size_t)l * 256 * 384, C.w<bf16_t>(W_UQ), 256, 384, 256, 0);
    conv_job(C, C.in[31] + (size_t)l * 128 * 512, C.w<bf16_t>(W_UKV), 128, 512, 128, 0);
    for (int d = 0; d < 2; ++d) {
        conv_job(C, C.in[19] + ((size_t)l * 2 + d) * 64 * 256, C.w<bf16_t>(W_W2) + (size_t)d * 256 * 64, 64, 256, 64, 0);
        conv_job(C, C.in[21] + ((size_t)l * 2 + d) * 64 * 256, C.w<bf16_t>(W_A2) + (size_t)d * 256 * 64, 64, 256, 64, 0);
    }
    conv_job(C, C.in[22] + (size_t)l * 128 * 256, C.w<bf16_t>(W_G2), 128, 256, 128, 0);
}

DI void phase_rowprep(const Ctx& C, int mode, int l) {
    const int lane = TIDX & 63, wave = TIDX >> 6;
    const float* mod = C.w<float>(WS_MOD); const float* mo = C.w<float>(WS_MO); bf16_t* h = C.w<bf16_t>(WS_HYS);
    const int lh = (mode == 0) ? 0 : (mode == 1 ? l : (l + 1 < NLAY ? l + 1 : -1));
    const float* gpost = (mode == 1) ? C.in[14] + l * 1024 : C.in[16] + l * 1024;
    const float* gpre = (mode == 1) ? C.in[15] + l * 1024 : C.in[13] + (lh < 0 ? 0 : lh) * 1024;
    const int goff = (mode == 1) ? 2048 : 5120, shoff = (mode == 1) ? 3072 : 0, scoff = (mode == 1) ? 4096 : 1024;
    for (int t = BIDX * 8 + wave; t < TT; t += gridDim.x * 8) {
        const int j = t < TC ? 0 : 1 + (t - TC) / 2048;
        f32x4 x[4];
        if (mode == 0) { const float* src = t < TC ? C.in[0] + (size_t)t * 1024 : C.in[1] + (size_t)(t - TC) * 1024;
#pragma unroll
            for (int i = 0; i < 4; ++i) x[i] = *(const f32x4*)(src + i * 256 + lane * 4); }
        else {
            const float* mg = mod + ((size_t)l * 3 + j) * 6144 + goff;
            f32x4 y[4]; float ss = 0.f;
#pragma unroll
            for (int i = 0; i < 4; ++i) { y[i] = *(const f32x4*)(mo + (size_t)t * 1024 + i * 256 + lane * 4); x[i] = *(const f32x4*)(C.out + (size_t)t * 1024 + i * 256 + lane * 4); ss += y[i][0] * y[i][0] + y[i][1] * y[i][1] + y[i][2] * y[i][2] + y[i][3] * y[i][3]; }
            ss = wavesum(ss); const float rs = rsqrtf(ss * (1.0f / 1024.0f) + 1e-6f);
#pragma unroll
            for (int i = 0; i < 4; ++i) { const f32x4 gp = *(const f32x4*)(gpost + i * 256 + lane * 4), gt = *(const f32x4*)(mg + i * 256 + lane * 4); x[i] = x[i] + gt * (y[i] * rs * gp); }
        }
#pragma unroll
        for (int i = 0; i < 4; ++i) *(f32x4*)(C.out + (size_t)t * 1024 + i * 256 + lane * 4) = x[i];
        if (lh >= 0) {
            const float* mb = mod + ((size_t)lh * 3 + j) * 6144;
            float ss = 0.f;
#pragma unroll
            for (int i = 0; i < 4; ++i) ss += x[i][0] * x[i][0] + x[i][1] * x[i][1] + x[i][2] * x[i][2] + x[i][3] * x[i][3];
            ss = wavesum(ss); const float rs = rsqrtf(ss * (1.0f / 1024.0f) + 1e-6f);
#pragma unroll
            for (int i = 0; i < 4; ++i) { const f32x4 g = *(const f32x4*)(gpre + i * 256 + lane * 4), sc = *(const f32x4*)(mb + scoff + i * 256 + lane * 4), sh = *(const f32x4*)(mb + shoff + i * 256 + lane * 4);
                const f32x4 hv = (x[i] * rs * g) * (sc + 1.0f) + sh; u32x2 w; w.x = pk2(hv[0], hv[1]); w.y = pk2(hv[2], hv[3]);
                *(u32x2*)(h + (size_t)t * 1024 + i * 256 + lane * 4) = w; }
        }
    }
}

constexpr int ZT_LD = 2856;
template <int K> DI f32x4 tile_gemm(const bf16_t* zt, int acol, const bf16_t* Bt, int n0, int lane) {
    f32x4 acc = {0.f, 0.f, 0.f, 0.f}; const int r = lane & 15, q = lane >> 4;
    const bf16_t* ap = zt + r * ZT_LD + acol + q * 8; const bf16_t* bp = Bt + (size_t)(n0 + r) * K + q * 8;
#pragma unroll
    for (int ks = 0; ks < K / 32; ++ks) { const bf16x8 a = *(const bf16x8*)(ap + ks * 32); const bf16x8 b = *(const bf16x8*)(bp + ks * 32); acc = __builtin_amdgcn_mfma_f32_16x16x32_bf16(a, b, acc, 0, 0, 0); }
    return acc;
}
DI float red_xor(float v, int span) { for (int o = 1; o < span; o <<= 1) v += __shfl_xor(v, o); return v; }

DI void prep_tile(const Ctx& C, int l, int item) {
    bf16_t* ZT = (bf16_t*)C.smem; float* KKs = (float*)(C.smem + 91392); float* PART = (float*)(C.smem + 91392 + 16384);
    const int tid = TIDX, lane = tid & 63, wave = tid >> 6, r16 = lane & 15, quad = lane >> 4;
    const bool cached = item >= 768;
    int t0, kidx0, seq, pos0; bool latent;
    if (!cached) { t0 = item * 16; latent = t0 >= TC; if (!latent) { seq = t0 >> 8; pos0 = t0 & 255; kidx0 = t0; } else { const int u = t0 - TC; seq = 32 + (u >> 11); pos0 = u & 2047; kidx0 = TC + (u >> 11) * 2560 + pos0; } }
    else { const int ct = item - 768, b = ct >> 5; pos0 = (ct & 31) * 16; seq = 32 + b; kidx0 = TC + b * 2560 + 2048 + pos0; latent = true; t0 = 0; }
    const bf16_t* zb = C.w<bf16_t>(WS_ZB);
    if (!cached) {
        for (int i = tid; i < 16 * 356; i += NTHR) { const int row = i / 356, ch = i % 356; *(u32x4*)(ZT + row * ZT_LD + ch * 8) = *(const u32x4*)(zb + (size_t)(t0 + row) * ZBW + ch * 8); }
    } else {
        const int b = seq - 32; const size_t rb = ((size_t)b * 4 + l) * 512 + pos0;
        for (int i = tid; i < 16 * 928; i += NTHR) { const int row = i / 928, e = i % 928; float v; int col;
            if (e < 128) { v = C.in[4][(rb + row) * 128 + e]; col = 1408 + e; }
            else if (e < 160) { v = C.in[5][(rb + row) * 32 + (e - 128)]; col = 1536 + (e - 128); }
            else if (e < 288) { v = C.in[6][(rb + row) * 128 + (e - 160)]; col = 1824 + (e - 160); }
            else if (e < 416) { v = C.in[7][(rb + row) * 128 + (e - 288)]; col = 1952 + (e - 288); }
            else if (e < 672) { v = C.in[8][(rb + row) * 256 + (e - 416)]; col = 2336 + (e - 416); }
            else { v = C.in[9][(rb + row) * 256 + (e - 672)]; col = 2592 + (e - 672); }
            ZT[row * ZT_LD + col] = f2bf(v); }
    }
    __syncthreads();
    const float* rope = C.w<float>(WS_ROPE);
    if (!cached) {
        const int tok = tid >> 5, sub = tid & 31, t = t0 + tok, pos = pos0 + tok; bf16_t* zr = ZT + tok * ZT_LD;
        const size_t crow = ((size_t)seq * 4 + l) * 256 + pos;
#pragma unroll
        for (int i = 0; i < 4; ++i) { const int c = sub * 4 + i; zr[768 + c] = f2bf(tanhf(bf2f(zr[768 + c]))); zr[1024 + c] = f2bf(sigmoidf_(bf2f(zr[1024 + c]))); }
        { float x[8]; float ss = 0.f;
#pragma unroll
          for (int i = 0; i < 8; ++i) { x[i] = bf2f(zr[1152 + sub * 8 + i]); ss += x[i] * x[i]; }
          ss = red_xor(ss, 32); const float rs = rsqrtf(ss * (1.0f / 256.0f) + 1e-6f);
#pragma unroll
          for (int i = 0; i < 8; ++i) zr[1152 + sub * 8 + i] = f2bf(x[i] * rs * C.in[28][l * 256 + sub * 8 + i]); }
        { float x[4]; float ss = 0.f;
#pragma unroll
          for (int i = 0; i < 4; ++i) { x[i] = bf2f(zr[1408 + sub * 4 + i]); ss += x[i] * x[i]; }
          ss = red_xor(ss, 32); const float rs = rsqrtf(ss * (1.0f / 128.0f) + 1e-6f);
#pragma unroll
          for (int i = 0; i < 4; ++i) { const float y = x[i] * rs * C.in[30][l * 128 + sub * 4 + i]; zr[1408 + sub * 4 + i] = f2bf(y); if (!latent) C.out[O_CKV + crow * 128 + sub * 4 + i] = y; } }
        { float x[8]; float ss = 0.f;
#pragma unroll
          for (int i = 0; i < 8; ++i) { x[i] = bf2f(zr[256 + sub * 8 + i]) * C.in[23][l * 256 + sub * 8 + i]; ss += x[i] * x[i]; }
          ss = red_xor(ss, 8); const float rs = rsqrtf(ss + 1e-12f);
          bf16_t* kkg = C.w<bf16_t>(R_KK) + (size_t)t * 256 + sub * 8;
#pragma unroll
          for (int i = 0; i < 8; ++i) { const float y = x[i] * rs; KKs[tok * 256 + sub * 8 + i] = y; kkg[i] = f2bf(y); } }
        { float x[8]; float ss = 0.f;
#pragma unroll
          for (int i = 0; i < 8; ++i) { x[i] = bf2f(zr[1568 + sub * 8 + i]); ss += x[i] * x[i]; }
          ss = red_xor(ss, 8); const float rs = rsqrtf(ss * (1.0f / 64.0f) + 1e-6f);
#pragma unroll
          for (int i = 0; i < 8; ++i) zr[1568 + sub * 8 + i] = f2bf(x[i] * rs * C.in[32][l * 64 + (sub & 7) * 8 + i]); }
        { float x[4]; float ss = 0.f;
#pragma unroll
          for (int i = 0; i < 4; ++i) { x[i] = bf2f(zr[1824 + sub * 4 + i]); ss += x[i] * x[i]; }
          ss = red_xor(ss, 16); const float rs = rsqrtf(ss * (1.0f / 64.0f) + 1e-6f);
#pragma unroll
          for (int i = 0; i < 4; ++i) { const float y = x[i] * rs * C.in[33][l * 64 + (sub & 15) * 4 + i]; zr[1824 + sub * 4 + i] = f2bf(y); if (!latent) C.out[O_GK + crow * 128 + sub * 4 + i] = y; } }
        if (!latent) {
            C.out[O_KPE + crow * 32 + sub] = bf2f(zr[1536 + sub]);
#pragma unroll
            for (int i = 0; i < 4; ++i) C.out[O_GV + crow * 128 + sub * 4 + i] = bf2f(zr[1952 + sub * 4 + i]);
#pragma unroll
            for (int i = 0; i < 8; ++i) { C.out[O_NK + crow * 256 + sub * 8 + i] = bf2f(zr[2336 + sub * 8 + i]); C.out[O_NV + crow * 256 + sub * 8 + i] = bf2f(zr[2592 + sub * 8 + i]); }
        }
        __syncthreads();
        if (latent) {
            if (tid < 256) { const int tk = tid >> 4, i = tid & 15, p = pos0 + tk, pi = (i < 8) ? (p >> 6) : (p & 63), f = i & 7;
                const float cs = rope[2048 + pi * 8 + f], sn = rope[2560 + pi * 8 + f]; bf16_t* z = ZT + tk * ZT_LD + 1536;
                const float x1 = bf2f(z[i]), x2 = bf2f(z[16 + i]); z[i] = f2bf(x1 * cs - x2 * sn); z[16 + i] = f2bf(x1 * sn + x2 * cs); }
            for (int e = tid; e < 16 * 6 * 32; e += NTHR) { const int tk = e / 192, r = e % 192, hd = r >> 5, i = r & 31, p = pos0 + tk, pi = (i < 16) ? (p >> 6) : (p & 63), f = i & 15;
                const float cs = rope[pi * 16 + f], sn = rope[1024 + pi * 16 + f]; bf16_t* z = ZT + tk * ZT_LD + (hd < 4 ? 1568 + hd * 64 : 1824 + (hd - 4) * 64);
                const float x1 = bf2f(z[i]), x2 = bf2f(z[32 + i]); z[i] = f2bf(x1 * cs - x2 * sn); z[32 + i] = f2bf(x1 * sn + x2 * cs); }
            __syncthreads();
        }
    }
    if (tid < 256) { const int tk = tid >> 4, hd = (tid >> 2) & 3, ch = tid & 3;
        *(u32x4*)(C.w<bf16_t>(A_KM) + ((size_t)hd * NKEY + kidx0 + tk) * 96 + 64 + ch * 8) = *(const u32x4*)(ZT + tk * ZT_LD + 1536 + ch * 8); }
    if (!cached) { const int tk = tid >> 5, ch = tid & 31; *(u32x4*)(C.w<bf16_t>(A_QG) + (size_t)(t0 + tk) * 256 + ch * 8) = *(const u32x4*)(ZT + tk * ZT_LD + 1568 + ch * 8); }
    if (tid < 256) { const int tk = tid >> 4, hd = (tid >> 3) & 1, ch = tid & 7;
        *(u32x4*)(C.w<bf16_t>(A_KG) + ((size_t)hd * NKEY + kidx0 + tk) * 64 + ch * 8) = *(const u32x4*)(ZT + tk * ZT_LD + 1824 + hd * 64 + ch * 8); }
    { const int tk = tid >> 5, hd = (tid >> 3) & 3, ch = tid & 7;
        *(u32x4*)(C.w<bf16_t>(A_KN) + ((size_t)hd * NKEY + kidx0 + tk) * 64 + ch * 8) = *(const u32x4*)(ZT + tk * ZT_LD + 2336 + hd * 64 + ch * 8); }
    { const int col = tid >> 2, tg = tid & 3; const bf16_t* z = ZT + (tg * 4) * ZT_LD + 1952 + col;
        u32x2 w; w.x = (unsigned)z[0] | ((unsigned)z[ZT_LD] << 16); w.y = (unsigned)z[2 * ZT_LD] | ((unsigned)z[3 * ZT_LD] << 16);
        *(u32x2*)(C.w<bf16_t>(A_VTG) + (size_t)col * NKEY + kidx0 + tg * 4) = w; }
#pragma unroll
    for (int rep = 0; rep < 2; ++rep) { const int it = tid + rep * NTHR, col = it >> 2, tg = it & 3; const bf16_t* z = ZT + (tg * 4) * ZT_LD + 2592 + col;
        u32x2 w; w.x = (unsigned)z[0] | ((unsigned)z[ZT_LD] << 16); w.y = (unsigned)z[2 * ZT_LD] | ((unsigned)z[3 * ZT_LD] << 16);
        *(u32x2*)(C.w<bf16_t>(A_VTN) + (size_t)col * NKEY + kidx0 + tg * 4) = w; }
    {
#pragma unroll
        for (int i = 0; i < 4; ++i) { const int nt = wave * 4 + i, hd = nt >> 3, sb = nt & 7;
            const f32x4 acc = tile_gemm<128>(ZT, 1408, C.w<bf16_t>(W_UKV), nt * 16, lane);
            if (sb < 4) { bf16_t* kp = C.w<bf16_t>(A_KM) + ((size_t)hd * NKEY + kidx0 + quad * 4) * 96 + sb * 16 + r16;
#pragma unroll
                for (int j = 0; j < 4; ++j) kp[j * 96] = f2bf(acc[j]); }
            else { u32x2 w; w.x = pk2(acc[0], acc[1]); w.y = pk2(acc[2], acc[3]);
                *(u32x2*)(C.w<bf16_t>(A_VTM) + ((size_t)hd * 64 + (sb - 4) * 16 + r16) * NKEY + kidx0 + quad * 4) = w; } }
    }
    if (!cached) {
        {
            const int d = wave >> 2; float* dec = C.w<float>(d ? R_DEC1 : R_DEC0);
#pragma unroll
            for (int i = 0; i < 4; ++i) { const int nt = (wave & 3) * 4 + i, c = nt * 16 + r16;
                const f32x4 acc = tile_gemm<64>(ZT, 768 + d * 64, C.w<bf16_t>(W_W2) + (size_t)d * 256 * 64, nt * 16, lane);
                const float w0 = C.in[18][((size_t)l * 2 + d) * 256 + c];
#pragma unroll
                for (int j = 0; j < 4; ++j) { const float x = -(w0 + acc[j]); const float sp = fmaxf(x, 0.f) + __logf(1.0f + __expf(-fabsf(x))); const float w = -sp - 0.5f;
                    dec[(size_t)(t0 + quad * 4 + j) * 256 + c] = __expf(-__expf(w)); } }
        }
        {
#pragma unroll
            for (int i = 0; i < 2; ++i) { const int nt = wave * 2 + i, c = nt * 16 + r16;
                const f32x4 ac0 = tile_gemm<64>(ZT, 896, C.w<bf16_t>(W_A2), nt * 16, lane);
                const f32x4 ac1 = tile_gemm<64>(ZT, 960, C.w<bf16_t>(W_A2) + (size_t)256 * 64, nt * 16, lane);
                const float a00 = C.in[20][((size_t)l * 2 + 0) * 256 + c], a01 = C.in[20][((size_t)l * 2 + 1) * 256 + c], ka = C.in[24][l * 256 + c], rk = C.in[25][l * 256 + c];
#pragma unroll
                for (int j = 0; j < 4; ++j) { const int tk = quad * 4 + j; const size_t o = (size_t)(t0 + tk) * 256 + c;
                    const float a0 = sigmoidf_(a00 + ac0[j]), a1 = sigmoidf_(a01 + ac1[j]);
                    const float k = bf2f(ZT[tk * ZT_LD + 256 + c]), r = bf2f(ZT[tk * ZT_LD + c]), kk = KKs[tk * 256 + c];
                    const float kd0 = k * (1.0f + (a0 - 1.0f) * ka), kd1 = k * (1.0f + (a1 - 1.0f) * ka);
                    C.w<bf16_t>(R_KD0)[o] = f2bf(kd0); C.w<bf16_t>(R_KD1)[o] = f2bf(kd1); C.w<bf16_t>(R_B0)[o] = f2bf(kk * a0); C.w<bf16_t>(R_B1)[o] = f2bf(kk * a1);
                    const float part = rowsum16(r * 0.5f * (kd0 + kd1) * rk);
                    if (r16 == 0) PART[tk * 16 + nt] = part; } }
        }
        {
#pragma unroll
            for (int i = 0; i < 2; ++i) { const int nt = wave * 2 + i, c = nt * 16 + r16;
                const f32x4 acc = tile_gemm<128>(ZT, 1024, C.w<bf16_t>(W_G2), nt * 16, lane);
#pragma unroll
                for (int j = 0; j < 4; ++j) C.w<bf16_t>(R_G)[(size_t)(t0 + quad * 4 + j) * 256 + c] = f2bf(acc[j]); }
        }
        {
            const int hd = wave >> 1, tb = (wave & 1) * 3; bf16_t* qm = C.w<bf16_t>(A_QM);
            f32x4 a0 = tile_gemm<256>(ZT, 1152, C.w<bf16_t>(W_UQ), hd * 96 + (tb + 0) * 16, lane);
            f32x4 a1 = tile_gemm<256>(ZT, 1152, C.w<bf16_t>(W_UQ), hd * 96 + (tb + 1) * 16, lane);
            f32x4 a2 = tile_gemm<256>(ZT, 1152, C.w<bf16_t>(W_UQ), hd * 96 + (tb + 2) * 16, lane);
            if (latent && (wave & 1)) {
#pragma unroll
                for (int j = 0; j < 4; ++j) { const int p = pos0 + quad * 4 + j, pi = (r16 < 8) ? (p >> 6) : (p & 63), f = r16 & 7;
                    const float cs = rope[2048 + pi * 8 + f], sn = rope[2560 + pi * 8 + f]; const float x1 = a1[j], x2 = a2[j]; a1[j] = x1 * cs - x2 * sn; a2[j] = x1 * sn + x2 * cs; }
            }
#pragma unroll
            for (int j = 0; j < 4; ++j) { bf16_t* qp = qm + (size_t)(t0 + quad * 4 + j) * 384 + hd * 96 + tb * 16 + r16; qp[0] = f2bf(a0[j]); qp[16] = f2bf(a1[j]); qp[32] = f2bf(a2[j]); }
        }
        __syncthreads();
        if (tid < 64) { const int tk = tid >> 2, hd = tid & 3; C.w<float>(R_BS)[(size_t)(t0 + tk) * 4 + hd] = PART[tk * 16 + hd * 4] + PART[tk * 16 + hd * 4 + 1] + PART[tk * 16 + hd * 4 + 2] + PART[tk * 16 + hd * 4 + 3]; }
    }
    __syncthreads();
}
DI void phase_prep(const Ctx& C, int l) { for (int item = BIDX; item < 832; item += gridDim.x) prep_tile(C, l, item); }

constexpr int ST_FLOATS = 5 * 32 * 64 + 32 * 16;
DI void scan_fill(const Ctx& C, float* st, int d, int tb, int n, int h, int g, int c, int i) {
    const int step = i >> 3, part = i & 7; const int s = c * 32 + step; const int tok = d ? tb + n - 1 - s : tb + s;
    const bf16_t* zb = C.w<bf16_t>(WS_ZB) + (size_t)tok * ZBW; const size_t o = (size_t)tok * 256 + h * 64 + part * 8;
    const u32x4 rr = *(const u32x4*)(zb + h * 64 + part * 8);
    const f32x4 w0 = *(const f32x4*)(C.w<float>(d ? R_DEC1 : R_DEC0) + o), w1 = *(const f32x4*)(C.w<float>(d ? R_DEC1 : R_DEC0) + o + 4);
    const u32x4 kd = *(const u32x4*)(C.w<bf16_t>(d ? R_KD1 : R_KD0) + o), kk = *(const u32x4*)(C.w<bf16_t>(R_KK) + o), bb = *(const u32x4*)(C.w<bf16_t>(d ? R_B1 : R_B0) + o);
    u32x4 vv = {0u, 0u, 0u, 0u}; if (part < 2) vv = *(const u32x4*)(zb + 512 + h * 64 + g * 16 + part * 8);
    float* p = st + step * 64 + part * 8;
#define EXP8(dst, u) do { *(f32x4*)(dst) = (f32x4){__uint_as_float((u).x << 16), __uint_as_float((u).x & 0xffff0000u), __uint_as_float((u).y << 16), __uint_as_float((u).y & 0xffff0000u)}; \
        *(f32x4*)((dst) + 4) = (f32x4){__uint_as_float((u).z << 16), __uint_as_float((u).z & 0xffff0000u), __uint_as_float((u).w << 16), __uint_as_float((u).w & 0xffff0000u)}; } while (0)
    EXP8(p, rr); *(f32x4*)(p + 2048) = w0; *(f32x4*)(p + 2048 + 4) = w1; EXP8(p + 4096, kd); EXP8(p + 6144, kk); EXP8(p + 8192, bb);
    if (part < 2) { float* pv = st + 10240 + step * 16 + part * 8; EXP8(pv, vv); }
#undef EXP8
}
typedef float f32x2 __attribute__((ext_vector_type(2)));
DI void scan_item(const Ctx& C, int l, int d, int seq, int h, int g) {
    const int tid = TIDX; const bool latent = seq >= 32;
    const int n = latent ? 2048 : 256, tb = latent ? TC + (seq - 32) * 2048 : seq * 256, nch = n / 32;
    float* buf = (float*)C.smem;
    const bool stager = tid >= 256; const int i = tid & 255, row = i >> 4, cgp = i & 15;
    f32x2 S01 = {0.f, 0.f}, S23 = {0.f, 0.f};
    if (!stager && latent) { const f32x4 s4 = *(const f32x4*)(C.in[3] + (((((size_t)(seq - 32) * 4 + l) * 2 + d) * 4 + h) * 64 + g * 16 + row) * 64 + cgp * 4); S01 = (f32x2){s4[0], s4[1]}; S23 = (f32x2){s4[2], s4[3]}; }
    float* yout = C.w<float>(d ? R_Y1 : R_Y0) + h * 64 + g * 16 + row;
    if (stager) scan_fill(C, buf, d, tb, n, h, g, 0, i);
    __syncthreads();
    for (int c = 0; c < nch; ++c) {
        const float* st = buf + (c & 1) * ST_FLOATS;
        if (stager) { if (c + 1 < nch) scan_fill(C, buf + ((c + 1) & 1) * ST_FLOATS, d, tb, n, h, g, c + 1, i); }
        else {
            const float* p = st + cgp * 4; const float* pv = st + 10240 + row;
#pragma unroll
            for (int hs = 0; hs < 2; ++hs) {
                float yk = 0.f;
#pragma unroll
                for (int ss = 0; ss < 16; ++ss) {
                    const int s = hs * 16 + ss;
                    const f32x4 r4 = *(const f32x4*)(p + s * 64), w4 = *(const f32x4*)(p + 2048 + s * 64), k4 = *(const f32x4*)(p + 4096 + s * 64), q4 = *(const f32x4*)(p + 6144 + s * 64), b4 = *(const f32x4*)(p + 8192 + s * 64);
                    const float v = pv[s * 16];
                    const f32x2 dq = S01 * (f32x2){q4[0], q4[1]} + S23 * (f32x2){q4[2], q4[3]};
                    const f32x2 t01 = S01 * (f32x2){w4[0], w4[1]} + (f32x2){k4[0], k4[1]} * v, t23 = S23 * (f32x2){w4[2], w4[3]} + (f32x2){k4[2], k4[3]} * v;
                    const float sa = -rowsum16(dq[0] + dq[1]);
                    S01 = (f32x2){b4[0], b4[1]} * sa + t01; S23 = (f32x2){b4[2], b4[3]} * sa + t23;
                    const f32x2 dy = S01 * (f32x2){r4[0], r4[1]} + S23 * (f32x2){r4[2], r4[3]};
                    const float y = rowsum16(dy[0] + dy[1]);
                    yk = (cgp == ss) ? y : yk;
                }
                const int sg = c * 32 + hs * 16 + cgp; const int tok = d ? tb + n - 1 - sg : tb + sg;
                yout[(size_t)tok * 256] = yk;
            }
        }
        __syncthreads();
    }
    if (!stager && !latent) *(f32x4*)(C.out + O_STATE + (((((size_t)seq * 4 + l) * 2 + d) * 4 + h) * 64 + g * 16 + row) * 64 + cgp * 4) = (f32x4){S01[0], S01[1], S23[0], S23[1]};
}

DI float xq_max(float x) { auto r = __builtin_amdgcn_permlane16_swap(__float_as_uint(x), __float_as_uint(x), false, false); x = fmaxf(__uint_as_float(r[0]), __uint_as_float(r[1]));
    auto r2 = __builtin_amdgcn_permlane32_swap(__float_as_uint(x), __float_as_uint(x), false, false); return fmaxf(__uint_as_float(r2[0]), __uint_as_float(r2[1])); }
DI float xq_sum(float x) { auto r = __builtin_amdgcn_permlane16_swap(__float_as_uint(x), __float_as_uint(x), false, false); x = __uint_as_float(r[0]) + __uint_as_float(r[1]);
    auto r2 = __builtin_amdgcn_permlane32_swap(__float_as_uint(x), __float_as_uint(x), false, false); return __uint_as_float(r2[0]) + __uint_as_float(r2[1]); }
struct AttnSt { f32x4 o0, o1, o2, o3; float m, l; };
template <int DK, bool NA>
DI void attn_step(AttnSt& A, const bf16x8 (&kf)[2 * (DK / 32)], const s16x4 (&vf)[8], const bf16x8 (&qf)[DK / 32], float sl2, const float* rb, int dr, int c, int cstart, int quad) {
    f32x4 st0 = {0.f, 0.f, 0.f, 0.f}, st1 = st0;
#pragma unroll
    for (int ks = 0; ks < DK / 32; ++ks) { st0 = __builtin_amdgcn_mfma_f32_16x16x32_bf16(kf[2 * ks], qf[ks], st0, 0, 0, 0); st1 = __builtin_amdgcn_mfma_f32_16x16x32_bf16(kf[2 * ks + 1], qf[ks], st1, 0, 0, 0); }
    float s[8];
#pragma unroll
    for (int j = 0; j < 4; ++j) { s[j] = st0[j] * sl2; s[4 + j] = st1[j] * sl2; }
    if (NA) {
        int c0 = c - 8; c0 = c0 < 0 ? 0 : (c0 > 48 ? 48 : c0);
#pragma unroll
        for (int j = 0; j < 8; ++j) { const int kc = cstart + (j >> 2) * 16 + quad * 4 + (j & 3); const bool ok = (kc >= c0) && (kc < c0 + 16);
            int dc = kc - c + 15; dc = dc < 0 ? 0 : (dc > 30 ? 30 : dc);
            s[j] = ok ? s[j] + rb[dr * 31 + dc] * 1.44269504f : -INFINITY; }
    }
    float mx = fmaxf(fmaxf(fmaxf(s[0], s[1]), fmaxf(s[2], s[3])), fmaxf(fmaxf(s[4], s[5]), fmaxf(s[6], s[7])));
    mx = xq_max(mx);
    const float mn = fmaxf(A.m, mx), alpha = __builtin_amdgcn_exp2f(A.m - mn); A.m = mn;
    float ps = 0.f;
#pragma unroll
    for (int j = 0; j < 8; ++j) { s[j] = __builtin_amdgcn_exp2f(s[j] - mn); ps += s[j]; }
    A.l = A.l * alpha + ps;
    A.o0 *= alpha; A.o1 *= alpha; A.o2 *= alpha; A.o3 *= alpha;
    u32x4 pw; pw.x = pg8::cvt_pk_bf16(s[0], s[1]); pw.y = pg8::cvt_pk_bf16(s[2], s[3]); pw.z = pg8::cvt_pk_bf16(s[4], s[5]); pw.w = pg8::cvt_pk_bf16(s[6], s[7]);
    const bf16x8 pf = __builtin_bit_cast(bf16x8, pw);
    A.o0 = __builtin_amdgcn_mfma_f32_16x16x32_bf16(__builtin_shufflevector(vf[0], vf[1], 0, 1, 2, 3, 4, 5, 6, 7), pf, A.o0, 0, 0, 0);
    A.o1 = __builtin_amdgcn_mfma_f32_16x16x32_bf16(__builtin_shufflevector(vf[2], vf[3], 0, 1, 2, 3, 4, 5, 6, 7), pf, A.o1, 0, 0, 0);
    A.o2 = __builtin_amdgcn_mfma_f32_16x16x32_bf16(__builtin_shufflevector(vf[4], vf[5], 0, 1, 2, 3, 4, 5, 6, 7), pf, A.o2, 0, 0, 0);
    A.o3 = __builtin_amdgcn_mfma_f32_16x16x32_bf16(__builtin_shufflevector(vf[6], vf[7], 0, 1, 2, 3, 4, 5, 6, 7), pf, A.o3, 0, 0, 0);
}
DI void attn_store(const AttnSt& A, bf16_t* op) {
    const float inv = 1.0f / xq_sum(A.l);
    { u32x2 w; w.x = pk2(A.o0[0] * inv, A.o0[1] * inv); w.y = pk2(A.o0[2] * inv, A.o0[3] * inv); *(u32x2*)(op) = w; }
    { u32x2 w; w.x = pk2(A.o1[0] * inv, A.o1[1] * inv); w.y = pk2(A.o1[2] * inv, A.o1[3] * inv); *(u32x2*)(op + 16) = w; }
    { u32x2 w; w.x = pk2(A.o2[0] * inv, A.o2[1] * inv); w.y = pk2(A.o2[2] * inv, A.o2[3] * inv); *(u32x2*)(op + 32) = w; }
    { u32x2 w; w.x = pk2(A.o3[0] * inv, A.o3[1] * inv); w.y = pk2(A.o3[2] * inv, A.o3[3] * inv); *(u32x2*)(op + 48) = w; }
}
constexpr int ATT_VLD = 72, ATT_BUF = 64 * 104 * 2 + 64 * ATT_VLD * 2;
template <int DK, bool NA>
DI void attn_block(const Ctx& C, const bf16_t* Qw, int qs, const bf16_t* Kd, const bf16_t* Vd, int nsb, float scale, bf16_t* Ow,
                   const bf16_t* Kwin, const bf16_t* Vwin, const float* rb, int qr, int r0, int qcolw) {
    constexpr int KLD = DK + 8, KCH = DK / 8;
    const int tid = TIDX, lane = tid & 63, r16 = lane & 15, quad = lane >> 4;
    unsigned char* sm = C.smem;
    bf16x8 qf0[DK / 32], qf1[DK / 32];
#pragma unroll
    for (int ks = 0; ks < DK / 32; ++ks) { qf0[ks] = *(const bf16x8*)(Qw + (size_t)r16 * qs + ks * 32 + quad * 8); qf1[ks] = *(const bf16x8*)(Qw + (size_t)(16 + r16) * qs + ks * 32 + quad * 8); }
    const f32x4 z4 = {0.f, 0.f, 0.f, 0.f};
    AttnSt A0{z4, z4, z4, z4, -1e30f, 0.f}, A1 = A0;
    const float sl2 = scale * 1.44269504f;
    const int kc0 = tid, kc1 = tid + NTHR; const bool has1 = kc1 < 64 * KCH;
    const int vdv = tid >> 3, vpt = tid & 7;
    u32x4 gk0, gk1 = {0u, 0u, 0u, 0u}, gv;
#define ATT_GLOAD(sb) do { const bf16_t* kb_ = Kd + (size_t)(sb) * 64 * DK; gk0 = *(const u32x4*)(kb_ + (size_t)kc0 * 8); if (has1) gk1 = *(const u32x4*)(kb_ + (size_t)kc1 * 8); \
        gv = *(const u32x4*)(Vd + (size_t)vdv * NKEY + (size_t)(sb) * 64 + vpt * 8); } while (0)
#define ATT_LWRITE(buf) do { bf16_t* ks_ = (bf16_t*)(sm + (buf) * ATT_BUF); bf16_t* vs_ = ks_ + 64 * 104; *(u32x4*)(ks_ + (kc0 / KCH) * KLD + (kc0 % KCH) * 8) = gk0; \
        if (has1) *(u32x4*)(ks_ + (kc1 / KCH) * KLD + (kc1 % KCH) * 8) = gk1; *(u32x4*)(vs_ + vdv * ATT_VLD + vpt * 8) = gv; } while (0)
    ATT_GLOAD(0); ATT_LWRITE(0);
    __syncthreads();
    if (NA) {
#pragma unroll
        for (int qt = 0; qt < 2; ++qt) {
            const int qcol = qcolw + qt * 16; int cs = qcol - 8; cs = cs < 0 ? 0 : (cs > 32 ? 32 : cs);
            for (int wr = 0; wr < 8; ++wr) {
                const bf16_t* kp = Kwin + ((size_t)(wr * 64 + cs) + r16) * DK + quad * 8; const bf16_t* vp = Vwin + (size_t)r16 * NKEY + wr * 64 + cs + quad * 4;
                bf16x8 kf[2 * (DK / 32)]; s16x4 vf[8];
#pragma unroll
                for (int ks = 0; ks < DK / 32; ++ks) { kf[2 * ks] = *(const bf16x8*)(kp + ks * 32); kf[2 * ks + 1] = *(const bf16x8*)(kp + 16 * DK + ks * 32); }
#pragma unroll
                for (int dt = 0; dt < 4; ++dt) { vf[2 * dt] = *(const s16x4*)(vp + (size_t)dt * 16 * NKEY); vf[2 * dt + 1] = *(const s16x4*)(vp + (size_t)dt * 16 * NKEY + 16); }
                if (qt == 0) attn_step<DK, true>(A0, kf, vf, qf0, sl2, rb, r0 + wr - qr + 7, qcol + r16, cs, quad);
                else attn_step<DK, true>(A1, kf, vf, qf1, sl2, rb, r0 + wr - qr + 7, qcol + r16, cs, quad);
            }
        }
    }
    for (int sb = 0; sb < nsb; ++sb) {
        if (sb + 1 < nsb) ATT_GLOAD(sb + 1);
        const bf16_t* ks_ = (const bf16_t*)(sm + (sb & 1) * ATT_BUF); const bf16_t* vs_ = ks_ + 64 * 104;
#pragma unroll
        for (int hb = 0; hb < 2; ++hb) {
            bf16x8 kf[2 * (DK / 32)]; s16x4 vf[8];
#pragma unroll
            for (int ks = 0; ks < DK / 32; ++ks) { kf[2 * ks] = *(const bf16x8*)(ks_ + (hb * 32 + r16) * KLD + ks * 32 + quad * 8); kf[2 * ks + 1] = *(const bf16x8*)(ks_ + (hb * 32 + 16 + r16) * KLD + ks * 32 + quad * 8); }
#pragma unroll
            for (int dt = 0; dt < 4; ++dt) { vf[2 * dt] = *(const s16x4*)(vs_ + (dt * 16 + r16) * ATT_VLD + hb * 32 + quad * 4); vf[2 * dt + 1] = *(const s16x4*)(vs_ + (dt * 16 + r16) * ATT_VLD + hb * 32 + 16 + quad * 4); }
            attn_step<DK, false>(A0, kf, vf, qf0, sl2, nullptr, 0, 0, 0, quad);
            attn_step<DK, false>(A1, kf, vf, qf1, sl2, nullptr, 0, 0, 0, quad);
        }
        __syncthreads();
        if (sb + 1 < nsb) ATT_LWRITE((sb + 1) & 1);
        __syncthreads();
    }
#undef ATT_GLOAD
#undef ATT_LWRITE
    attn_store(A0, Ow + (size_t)r16 * 256 + quad * 4);
    attn_store(A1, Ow + (size_t)(16 + r16) * 256 + quad * 4);
}
DI void attn_item(const Ctx& C, int l, int kind, int seq, int hd, int qc) {
    const int wave = TIDX >> 6; const bool latent = seq >= 32;
    const int tb = latent ? TC + (seq - 32) * 2048 : seq * 256, koff = latent ? TC + (seq - 32) * 2560 : seq * 256;
    const int q0 = qc * 256 + wave * 32, tq = tb + q0;
    bf16_t* ys = C.w<bf16_t>(WS_HYS);
    const int nsb = latent ? 40 : 4;
    if (kind == 0) {
        attn_block<96, false>(C, C.w<bf16_t>(A_QM) + (size_t)tq * 384 + hd * 96, 384, C.w<bf16_t>(A_KM) + ((size_t)hd * NKEY + koff) * 96, C.w<bf16_t>(A_VTM) + (size_t)hd * 64 * NKEY + koff, nsb,
                              0.10206207261596575f, ys + ((size_t)1 * TT + tq) * 256 + hd * 64, nullptr, nullptr, nullptr, 0, 0, 0);
    } else if (kind == 1) {
        const int kvh = hd >> 1;
        attn_block<64, false>(C, C.w<bf16_t>(A_QG) + (size_t)tq * 256 + hd * 64, 256, C.w<bf16_t>(A_KG) + ((size_t)kvh * NKEY + koff) * 64, C.w<bf16_t>(A_VTG) + (size_t)kvh * 64 * NKEY + koff, nsb,
                              0.125f, ys + ((size_t)2 * TT + tq) * 256 + hd * 64, nullptr, nullptr, nullptr, 0, 0, 0);
    } else {
        const bf16_t* Q = C.w<bf16_t>(WS_ZB) + (size_t)tq * ZBW + 2080 + hd * 64; const bf16_t* K = C.w<bf16_t>(A_KN) + ((size_t)hd * NKEY + koff) * 64; const bf16_t* Vt = C.w<bf16_t>(A_VTN) + (size_t)hd * 64 * NKEY + koff;
        bf16_t* O = ys + ((size_t)3 * TT + tq) * 256 + hd * 64;
        if (!latent) attn_block<64, false>(C, Q, ZBW, K, Vt, 4, 0.125f, O, nullptr, nullptr, nullptr, 0, 0, 0);
        else { const int qr = q0 >> 6, qcolw = q0 & 63; int r0 = qr - 4; r0 = r0 < 0 ? 0 : (r0 > 24 ? 24 : r0);
            attn_block<64, true>(C, Q, ZBW, K + (size_t)2048 * 64, Vt + 2048, 8, 0.125f, O, K + (size_t)(r0 * 64) * 64, Vt + r0 * 64, C.in[34] + ((size_t)l * 4 + hd) * 15 * 31, qr, r0, qcolw); }
    }
}
constexpr int N_MIX = 64 + 128 + 64 + 1024 + 384;
DI void phase_mix(const Ctx& C, int l) {
    unsigned* ctr = C.w<unsigned>(WS_CTL) + 16 * l + 64 * C.rep; volatile int* sitem = (volatile int*)(C.smem + LDS_MAIN);
    for (;;) {
        __syncthreads();
        if (TIDX == 0) *sitem = (int)atomicAdd(ctr, 1u);
        __syncthreads();
        const int item = __builtin_amdgcn_readfirstlane(*sitem);
        if (item >= N_MIX) break;
        if (item < 64) { const int chain = item >> 2; scan_item(C, l, chain >> 3, 32 + ((chain >> 2) & 1), chain & 3, item & 3); }
        else if (item < 192) { const int i = item - 64, r = i & 63; attn_item(C, l, i >> 6, 32 + (r >> 5), (r >> 3) & 3, r & 7); }
        else if (item < 256) { const int i = item - 192; attn_item(C, l, 2, 32 + (i >> 5), (i >> 3) & 3, i & 7); }
        else if (item < 1280) { const int i = item - 256, chain = i >> 2; scan_item(C, l, chain >> 7, (chain >> 2) & 31, chain & 3, i & 3); }
        else { const int i = item - 1280, r = i & 127; attn_item(C, l, i >> 7, r >> 2, r & 3, 0); }
    }
}
DI void phase_post(const Ctx& C, int l) {
    const int lane = TIDX & 63, wave = TIDX >> 6, col = lane * 4, hd = lane >> 4;
    const f32x4 lg = *(const f32x4*)(C.in[26] + l * 256 + col), lb = *(const f32x4*)(C.in[27] + l * 256 + col);
    for (int t = BIDX * 8 + wave; t < TT; t += gridDim.x * 8) {
        const size_t o = (size_t)t * 256 + col;
        f32x4 y = *(const f32x4*)(C.w<float>(R_Y0) + o) + *(const f32x4*)(C.w<float>(R_Y1) + o);
        const float mu = rowsum16(y[0] + y[1] + y[2] + y[3]) * (1.0f / 64.0f);
        const f32x4 dlt = y - mu; const float var = rowsum16(dlt[0] * dlt[0] + dlt[1] * dlt[1] + dlt[2] * dlt[2] + dlt[3] * dlt[3]) * (1.0f / 64.0f);
        const float rs = rsqrtf(var + 64e-5f);
        const u32x2 vw = *(const u32x2*)(C.w<bf16_t>(WS_ZB) + (size_t)t * ZBW + 512 + col), gw = *(const u32x2*)(C.w<bf16_t>(R_G) + o);
        const f32x4 v = {__uint_as_float(vw.x << 16), __uint_as_float(vw.x & 0xffff0000u), __uint_as_float(vw.y << 16), __uint_as_float(vw.y & 0xffff0000u)};
        const f32x4 g = {__uint_as_float(gw.x << 16), __uint_as_float(gw.x & 0xffff0000u), __uint_as_float(gw.y << 16), __uint_as_float(gw.y & 0xffff0000u)};
        const float bs = C.w<float>(R_BS)[(size_t)t * 4 + hd];
        const f32x4 r = (dlt * rs * lg + lb + v * bs) * g;
        u32x2 w; w.x = pk2(r[0], r[1]); w.y = pk2(r[2], r[3]);
        *(u32x2*)(C.w<bf16_t>(WS_HYS) + o) = w;
    }
}

constexpr int N_PHASES = 2 + NLAY * 10;
template <int PH> DI void run_phase(const Ctx& C, PG8_LAS unsigned char* lds) {
    if constexpr (PH == 0) { phase_mod(C); __syncthreads(); phase_convert(C, 0); }
    else if constexpr (PH == 1) phase_rowprep(C, 0, 0);
    else {
        constexpr int l = (PH - 2) / 10, s = (PH - 2) % 10;
        if constexpr (s == 0) { pg8::Gemm g{C.w<bf16_t>(WS_HYS), C.w<bf16_t>(W_IN), TT, NZ, DM, 1 << 20, 0}; pg8::StaticOrder S; S.init(TT, NZ, gridDim.x, BIDX);
            EpiZ E{C.w<bf16_t>(WS_ZB), C.w<bf16_t>(WS_GL)}; pg8::gemm_phase<EpiZ, pg8::StaticOrder>(lds, g, S, E, nullptr); }
        else if constexpr (s == 1) phase_prep(C, l);
        else if constexpr (s == 2) phase_mix(C, l);
        else if constexpr (s == 3) phase_post(C, l);
        else if constexpr (s == 4) { pg8::Gemm g{C.w<bf16_t>(WS_HYS), C.w<bf16_t>(W_BR), TT, 4096, 256, 4, (size_t)TT * 256 * 2}; pg8::StaticOrder S; S.init(TT, 4096, gridDim.x, BIDX);
            EpiGate E{C.w<bf16_t>(WS_GL), C.w<bf16_t>(WS_GP)}; pg8::gemm_phase<EpiGate, pg8::StaticOrder>(lds, g, S, E, nullptr); }
        else if constexpr (s == 5) { pg8::Gemm g{C.w<bf16_t>(WS_GP), C.w<bf16_t>(W_O4), TT, 1024, 4096, 1 << 20, 0}; pg8::StaticOrder S; S.init(TT, 1024, gridDim.x, BIDX);
            pg8::EpiF32 E{C.w<float>(WS_MO), 1024, nullptr}; pg8::gemm_phase<pg8::EpiF32, pg8::StaticOrder>(lds, g, S, E, nullptr); }
        else if constexpr (s == 6) phase_rowprep(C, 1, l);
        else if constexpr (s == 7) { pg8::Gemm g{C.w<bf16_t>(WS_HYS), C.w<bf16_t>(W_GU), TT, 5632, DM, 1 << 20, 0}; pg8::StaticOrder S; S.init(TT, 5632, gridDim.x, BIDX);
            EpiSwiGLU E{C.w<bf16_t>(WS_GL)}; pg8::gemm_phase<EpiSwiGLU, pg8::StaticOrder>(lds, g, S, E, nullptr); }
        else if constexpr (s == 8) { pg8::Gemm g{C.w<bf16_t>(WS_GL), C.w<bf16_t>(W_DN), TT, 1024, FF, 1 << 20, 0}; pg8::StaticOrder S; S.init(TT, 1024, gridDim.x, BIDX);
            pg8::EpiF32 E{C.w<float>(WS_MO), 1024, nullptr}; pg8::gemm_phase<pg8::EpiF32, pg8::StaticOrder>(lds, g, S, E, nullptr); }
        else { phase_rowprep(C, 2, l); if constexpr (l + 1 < NLAY) { __syncthreads(); phase_convert(C, l + 1); } }
    }
}
template <int PH> DI void run_all(const Params& P, unsigned char* smem, cg::grid_group& grid) {
    if constexpr (PH < N_PHASES) {
#ifdef ONLY_S
        if constexpr (PH >= 2 && (PH - 2) % 10 == ONLY_S)
#endif
        if (P.ph_lo <= PH && PH < P.ph_hi) {
            Ctx C; { size_t z_ = 0; KIn i_ = (KIn)__builtin_amdgcn_kernarg_segment_ptr(); asm volatile("" : "+s"(z_), "+s"(i_)); C.ws = P.ws + z_; C.out = P.out + z_; C.in = i_; C.smem = smem; }
            run_phase<PH>(C, (PG8_LAS unsigned char*)smem);
#ifdef REP_MASK
            if constexpr (PH >= 2 && ((REP_MASK >> ((PH - 2) % 10)) & 1)) { for (int rep_ = 0; rep_ < REP_N; ++rep_) { grid.sync(); C.rep = rep_ + 1; run_phase<PH>(C, (PG8_LAS unsigned char*)smem); } }
#endif
            if (PH + 1 < P.ph_hi) grid.sync();
        }
        run_all<PH + 1>(P, smem, grid);
    }
}
__global__ void __launch_bounds__(NTHR) mega(Params P) {
    extern __shared__ __attribute__((aligned(16))) unsigned char smem[];
    cg::grid_group grid = cg::this_grid();
    run_all<0>(P, smem, grid);
}

extern "C" void kernel_launch(void* const* d_in, const int* in_sizes, int n_in, void* d_out, int out_size, void* d_ws, size_t ws_size, hipStream_t stream) {
    static int grid_blocks = 0;
    if (grid_blocks == 0) {
        int dev = 0, cus = 0, per_cu = 0;
        hipGetDevice(&dev); hipDeviceGetAttribute(&cus, hipDeviceAttributeMultiprocessorCount, dev);
        if (hipFuncSetAttribute((const void*)mega, hipFuncAttributeMaxDynamicSharedMemorySize, LDS_BYTES) != hipSuccess) { fprintf(stderr, "hipFuncSetAttribute failed\n"); grid_blocks = -1; return; }
        hipOccupancyMaxActiveBlocksPerMultiprocessor(&per_cu, (const void*)mega, NTHR, LDS_BYTES);
        if (per_cu < 1) per_cu = 1;
        grid_blocks = cus * (per_cu > 1 ? 1 : per_cu);
        if (n_in != 40 || ws_size < WS_END) { fprintf(stderr, "kernel_launch: unexpected n_in %d or workspace %zu < %zu\n", n_in, ws_size, (size_t)WS_END); grid_blocks = -1; return; }
    }
    if (grid_blocks < 0) return;
    hipMemsetAsync((char*)d_ws + WS_CTL, 0, 4096, stream);
    Params P{};
    for (int i = 0; i < 40; ++i) P.in[i] = (const float*)d_in[i];
    P.out = (float*)d_out; P.ws = (unsigned char*)d_ws; P.ph_lo = 0; P.ph_hi = N_PHASES;
    void* args[] = {&P};
    hipError_t e = hipLaunchCooperativeKernel((const void*)mega, dim3(grid_blocks), dim3(NTHR), args, LDS_BYTES, stream);
    if (e != hipSuccess) fprintf(stderr, "cooperative launch failed: %s (grid %d)\n", hipGetErrorString(e), grid_blocks);
}
```

```cpp
#include <hip/hip_runtime.h>
#include <hip/hip_cooperative_groups.h>
#include <cstdio>
namespace cg = cooperative_groups;

__device__ __forceinline__ int ltid() { int t = (int)threadIdx.x; asm volatile("" : "+v"(t)); return t; }
__device__ __forceinline__ int lbid() { int t = (int)blockIdx.x; asm volatile("" : "+s"(t)); return t; }
#define TIDX ltid()
#define BIDX lbid()


#define XB_TMO      128
#define XB_XCNT(j)  (256  + 64 * (j))
#define XB_XSUB(j)  (1280 + 64 * (j))
#define XB_XGEN(j)  (2304 + 64 * (j))
#define XB_TOP      3328
#define XB_TOPGEN   3392
#define XCD_BAR_WORDS 3456
#define XB_SPIN_CAP (1u << 18)
#define LAS __attribute__((address_space(3)))

__device__ __forceinline__ unsigned xb_ld(unsigned* p)              { return __hip_atomic_load(p, __ATOMIC_RELAXED, __HIP_MEMORY_SCOPE_AGENT); }
__device__ __forceinline__ unsigned xb_add(unsigned* p, unsigned v) { return __hip_atomic_fetch_add(p, v, __ATOMIC_RELAXED, __HIP_MEMORY_SCOPE_AGENT); }
__device__ __forceinline__ unsigned xb_xcc_id() { return (unsigned)__builtin_amdgcn_s_getreg((3 << 11) | 20) & 0xFu; }
#define XB_SPIN(cond, bar) do { unsigned _sp = 0; while (cond) { __builtin_amdgcn_s_sleep(1); \
    if ((++_sp & 255u) == 0u) { if (xb_ld(&(bar)[XB_TMO])) break; if (_sp > XB_SPIN_CAP) { atomicAdd(&(bar)[XB_TMO], 1u); break; } } } } while (0)

struct XcdBarrier {
    unsigned* bar; unsigned x;
    volatile LAS unsigned* st;
};

__device__ __forceinline__ XcdBarrier xcd_barrier_post(unsigned* bar, volatile LAS unsigned* st) {
    XcdBarrier b; b.bar = bar; b.x = xb_xcc_id(); b.st = st;
    if (threadIdx.x == 0) (void)xb_add(&bar[XB_XCNT(b.x)], 1u);
    return b;
}
__device__ __forceinline__ void xcd_barrier_complete(unsigned* bar, unsigned x, unsigned& nloc, unsigned& nx) {
    const unsigned G = gridDim.x * gridDim.y * gridDim.z;
    unsigned sum, cnt, mine, sp = 0u;
    for (;;) {
        sum = 0u; cnt = 0u; mine = 0u;
#pragma unroll
        for (unsigned j = 0; j < 16; ++j) { const unsigned c = xb_ld(&bar[XB_XCNT(j)]); sum += c; cnt += (c > 0u) ? 1u : 0u; mine = (j == x) ? c : mine; }
        if (sum == G) break;
        __builtin_amdgcn_s_sleep(1);
        if ((++sp & 255u) == 0u) { if (xb_ld(&bar[XB_TMO])) break; if (sp > XB_SPIN_CAP) { atomicAdd(&bar[XB_TMO], 1u); break; } }
    }
    nloc = mine > 0u ? mine : 1u; nx = cnt > 0u ? cnt : 1u;
}

__device__ __forceinline__ void xcd_barrier(const XcdBarrier& b) {
    asm volatile("s_waitcnt vmcnt(0)" ::: "memory");
    __syncthreads();
    if (threadIdx.x == 0) {
        unsigned* bar = b.bar;
        __builtin_amdgcn_s_waitcnt(0);
        unsigned nloc = b.st[0], nx = b.st[1];
        if (nloc == 0u) { xcd_barrier_complete(bar, b.x, nloc, nx); b.st[0] = nloc; b.st[1] = nx; }
        const unsigned old = xb_add(&bar[XB_XSUB(b.x)], 1u);
        const unsigned gen = old / nloc;
        if (old + 1u == (gen + 1u) * nloc) {
            __builtin_amdgcn_fence(__ATOMIC_RELEASE, "agent");
            asm volatile("s_waitcnt vmcnt(0)" ::: "memory");
            const unsigned og = xb_add(&bar[XB_TOP], 1u);
            const unsigned tg = og / nx;
            if (og + 1u == (tg + 1u) * nx) xb_add(&bar[XB_TOPGEN], 1u);
            else XB_SPIN(xb_ld(&bar[XB_TOPGEN]) == tg, bar);
            __builtin_amdgcn_fence(__ATOMIC_ACQUIRE, "agent");
            xb_add(&bar[XB_XGEN(b.x)], 1u);
            asm volatile("s_waitcnt vmcnt(0)" ::: "memory");
        } else {
            XB_SPIN(xb_ld(&bar[XB_XGEN(b.x)]) == gen, bar);
            __builtin_amdgcn_fence(__ATOMIC_ACQUIRE, "agent");
            asm volatile("s_waitcnt vmcnt(0)" ::: "memory");
        }
    }
    __syncthreads();
}

namespace pg8 {
#define PG8_LAS __attribute__((address_space(3)))
typedef unsigned short bf16_t;
typedef short bf16x8 __attribute__((ext_vector_type(8)));
typedef float f32x4 __attribute__((ext_vector_type(4)));
typedef unsigned u32x4 __attribute__((ext_vector_type(4)));
constexpr int BM = 256, BK = 64, HALF = 128, HTB = HALF * BK * 2  , STAGE_BYTES = 8 * HTB, NXCD = 8, WGM = 8;

__host__ __device__ __forceinline__ int lds_byte(int r, int c) { const int st = (r >> 4) * 2 + (c >> 5), rr = r & 15, cc = c & 31, ob = rr * 64 + cc * 2; return st * 1024 + (ob ^ (((ob >> 9) & 1) << 5)); }
__host__ __device__ __forceinline__ void stage_rc(int b, int& R, int& C) { const int st = b / 1024, sb = b % 1024, swz = sb ^ (((sb >> 9) & 1) << 5); R = (st >> 1) * 16 + swz / 64; C = (st & 1) * 32 + (swz % 64) / 2; }
__host__ __device__ __forceinline__ int perm32(int rho) { const int n = rho >> 4, i = rho & 15; return 8 * (i >> 2) + 4 * n + (i & 3); }

struct Unit { int pm, pn; };
struct Gemm { const bf16_t* A; const bf16_t* Bt; int M, N, K; int ppg; size_t ags; };

struct StaticOrder {
    int nM, nN, nwg, G, c;
    __host__ __device__ void init(int M, int N, int G_, int c_) { nM = M / BM; nN = N / BM; nwg = nM * nN; G = G_; c = c_; }
    __host__ __device__ bool next(int i, Unit& u) const {
        const long L = (long)i * G + c; if (L >= nwg) return false;
        int wgid = (int)L; { const int q = nwg / NXCD, r = nwg % NXCD, xcd = wgid % NXCD, off = wgid / NXCD; wgid = (xcd < r ? xcd * (q + 1) : r * (q + 1) + (xcd - r) * q) + off; }
        const int nig = WGM * nN, gid = wgid / nig, fm = gid * WGM, gsz = (nM - fm) < WGM ? (nM - fm) : WGM;
        u.pm = fm + ((wgid % nig) % gsz); u.pn = (wgid % nig) / gsz; return true;
    }
    __device__ __forceinline__ void a_ready(const Unit&) const {}
    __device__ __forceinline__ void done(const Unit&) const {}
};
__device__ __forceinline__ unsigned cvt_pk_bf16(float lo, float hi) { unsigned r; asm volatile("v_cvt_pk_bf16_f32 %0, %1, %2" : "=v"(r) : "v"(lo), "v"(hi)); return r; }
typedef float f32x2 __attribute__((ext_vector_type(2)));
struct EpiF32 {
    static constexpr bool PERM = false, AFTER_DRAIN = false;
    float* C; int ldc; const float* bias;
    __device__ __forceinline__ void operator()(const f32x4 (&acc)[2][2][4][2], const Unit& u, int wr, int wc, int fr, int fq) const {
        const int row0 = u.pm * BM + wr * 64 + fr, col0 = u.pn * BM + wc * 32 + 4 * fq;
        f32x4 bv[2][2];
#pragma unroll
        for (int bj = 0; bj < 2; ++bj)
#pragma unroll
            for (int n = 0; n < 2; ++n) bv[bj][n] = bias ? *(const f32x4*)(bias + col0 + bj * HALF + n * 16) : (f32x4){0.f, 0.f, 0.f, 0.f};
#pragma unroll
        for (int ai = 0; ai < 2; ++ai)
#pragma unroll
            for (int m = 0; m < 4; ++m) { float* rowp = C + (size_t)(row0 + ai * HALF + m * 16) * ldc + col0;
#pragma unroll
                for (int bj = 0; bj < 2; ++bj)
#pragma unroll
                    for (int n = 0; n < 2; ++n) *(f32x4*)(rowp + bj * HALF + n * 16) = acc[ai][bj][m][n] + bv[bj][n]; }
    }
};
template <class Epi, class Sched, bool STAMP = false>
__device__ __forceinline__ void gemm_phase(PG8_LAS unsigned char* lds, const Gemm g, const Sched& S, const Epi& E, unsigned long long* stamps) {
    const int tid = TIDX, wid = __builtin_amdgcn_readfirstlane(tid >> 6), lane = tid & 63, wr = wid >> 2, wc = wid & 3, fr = lane & 15, fq = lane >> 4;
    const int K = g.K, nt = K / BK;
    int ts_lo = 0, ts_hi = 0, nts = 0;
#define PG8_STAMP() do { if (STAMP && wid == 0 && nts < 64) { const unsigned long long _c = (unsigned long long)clock64(); \
        ts_lo = (lane == nts) ? (int)(unsigned)_c : ts_lo; ts_hi = (lane == nts) ? (int)(unsigned)(_c >> 32) : ts_hi; ++nts; } } while (0)
    PG8_STAMP();
    unsigned voffA[2], voffB[2];
#pragma unroll
    for (int i = 0; i < 2; ++i) { int R, C; stage_rc(tid * 16 + i * 8192, R, C); const int Rb = Epi::PERM ? ((R & ~31) + perm32(R & 31)) : R;
        voffA[i] = (unsigned)(R * K + C) * 2u; voffB[i] = (unsigned)(Rb * K + C) * 2u; }
    const size_t kstep = (size_t)(BK * 2);
    const size_t hstep = (size_t)HALF * K * 2;
    const size_t tstep = 2 * hstep;
    const unsigned ldsw = (unsigned)wid * 1024u;
    const int aoff = lds_byte(wr * 64 + fr, fq * 8), boff = lds_byte(wc * 32 + fr, fq * 8);
#define PG8_SA(b, h) (((b) * 2 + (h)) * HTB)
#define PG8_SB(b, h) ((4 + (b) * 2 + (h)) * HTB)
#define PG8_STAGE(bufoff, gbase, voff) do { _Pragma("unroll") for (int _i = 0; _i < 2; ++_i) \
        __builtin_amdgcn_global_load_lds((const unsigned*)((const char*)(gbase) + (voff)[_i]), (PG8_LAS unsigned*)(lds + (bufoff) + ldsw + _i * 8192), 16, 0, 0); } while (0)
#define PG8_LDA(dst, b, h) do { _Pragma("unroll") for (int m = 0; m < 4; ++m) _Pragma("unroll") for (int k = 0; k < 2; ++k) dst[m][k] = *(const PG8_LAS bf16x8*)(lds + PG8_SA(b, h) + aoff + m * 2048 + k * 1024); } while (0)
#define PG8_LDB(dst, b, h) do { _Pragma("unroll") for (int n = 0; n < 2; ++n) _Pragma("unroll") for (int k = 0; k < 2; ++k) dst[n][k] = *(const PG8_LAS bf16x8*)(lds + PG8_SB(b, h) + boff + n * 2048 + k * 1024); } while (0)
#define PG8_MMA(ai, bj, At, Bt) do { __builtin_amdgcn_s_setprio(1); _Pragma("unroll") for (int m = 0; m < 4; ++m) _Pragma("unroll") for (int n = 0; n < 2; ++n) _Pragma("unroll") for (int k = 0; k < 2; ++k) \
        acc[ai][bj][m][n] = __builtin_amdgcn_mfma_f32_16x16x32_bf16(Bt[n][k], At[m][k], acc[ai][bj][m][n], 0, 0, 0); __builtin_amdgcn_s_setprio(0); } while (0)
#define PG8_WAIT_V(n) asm volatile("s_waitcnt vmcnt(" #n ")" ::: "memory")
#define PG8_WAIT_L(n) asm volatile("s_waitcnt lgkmcnt(" #n ")" ::: "memory")
#define PG8_BAR __builtin_amdgcn_s_barrier()
#define PG8_SCHED __builtin_amdgcn_sched_barrier(0)
    Unit cur, nxt; int ui = 0;
    if (!S.next(0, cur)) return;
    f32x4 acc[2][2][4][2];
#pragma unroll
    for (int a = 0; a < 2; ++a)
#pragma unroll
        for (int b = 0; b < 2; ++b)
#pragma unroll
            for (int m = 0; m < 4; ++m)
#pragma unroll
                for (int n = 0; n < 2; ++n) acc[a][b][m][n] = (f32x4){0.f, 0.f, 0.f, 0.f};
    bf16x8 At[4][2], B0[2][2], B1[2][2];
    const char* cA = (const char*)g.A + (size_t)cur.pm * tstep + (size_t)(cur.pn / g.ppg) * g.ags; const char* cB = (const char*)g.Bt + (size_t)cur.pn * tstep;
    S.a_ready(cur);
    PG8_STAGE(PG8_SB(0, 0), cB, voffB); PG8_STAGE(PG8_SA(0, 0), cA, voffA); PG8_STAGE(PG8_SB(0, 1), cB + hstep, voffB); PG8_STAGE(PG8_SA(0, 1), cA + hstep, voffA);
    if (wr == 1) PG8_BAR;
    PG8_WAIT_V(4); PG8_BAR;
    PG8_STAGE(PG8_SB(1, 0), cB + kstep, voffB); PG8_STAGE(PG8_SA(1, 0), cA + kstep, voffA); PG8_STAGE(PG8_SB(1, 1), cB + hstep + kstep, voffB);
    PG8_WAIT_V(6); PG8_BAR;
    PG8_STAMP();
    for (;;) {
        const bool has_next = S.next(ui + 1, nxt);
        const char* nA = has_next ? (const char*)g.A + (size_t)nxt.pm * tstep + (size_t)(nxt.pn / g.ppg) * g.ags : cA; const char* nB = has_next ? (const char*)g.Bt + (size_t)nxt.pn * tstep : cB;
#pragma unroll 1
        for (int t = 0; t < nt; t += 2) {
            const bool last = (t == nt - 2);
            const char* a1 = cA + (size_t)(t + 1) * kstep;
            const char* a2 = last ? nA : cA + (size_t)(t + 2) * kstep; const char* b2 = last ? nB : cB + (size_t)(t + 2) * kstep;
            const char* a3 = a2 + kstep; const char* b3 = b2 + kstep;
            if (last && has_next) S.a_ready(nxt);
            PG8_LDB(B0, 0, 0); PG8_SCHED; PG8_LDA(At, 0, 0); PG8_STAGE(PG8_SA(1, 1), a1 + hstep, voffA);
            PG8_WAIT_L(8); PG8_BAR; PG8_WAIT_L(0); PG8_MMA(0, 0, At, B0); PG8_BAR; PG8_SCHED;
            PG8_LDB(B1, 0, 1); PG8_STAGE(PG8_SB(0, 0), b2, voffB);
            PG8_BAR; PG8_WAIT_L(0); PG8_MMA(0, 1, At, B1); PG8_BAR;
            PG8_LDA(At, 0, 1); PG8_STAGE(PG8_SA(0, 0), a2, voffA);
            PG8_BAR; PG8_WAIT_L(0); PG8_MMA(1, 0, At, B0); PG8_BAR; PG8_SCHED;
            PG8_STAGE(PG8_SB(0, 1), b2 + hstep, voffB);
            PG8_WAIT_V(6); PG8_BAR; PG8_MMA(1, 1, At, B1); PG8_BAR;
            PG8_LDB(B0, 1, 0); PG8_SCHED; PG8_LDA(At, 1, 0); PG8_STAGE(PG8_SA(0, 1), a2 + hstep, voffA);
            PG8_WAIT_L(8); PG8_BAR; PG8_WAIT_L(0); PG8_MMA(0, 0, At, B0); PG8_BAR; PG8_SCHED;
            PG8_LDB(B1, 1, 1); PG8_STAGE(PG8_SB(1, 0), b3, voffB);
            PG8_BAR; PG8_WAIT_L(0); PG8_MMA(0, 1, At, B1); PG8_BAR;
            PG8_LDA(At, 1, 1); PG8_STAGE(PG8_SA(1, 0), a3, voffA);
            PG8_BAR; PG8_WAIT_L(0); PG8_MMA(1, 0, At, B0); PG8_BAR; PG8_SCHED;
            PG8_STAGE(PG8_SB(1, 1), b3 + hstep, voffB);
            PG8_WAIT_V(6); PG8_BAR; PG8_MMA(1, 1, At, B1); PG8_BAR;
        }
        PG8_STAMP();
        if constexpr (!Epi::AFTER_DRAIN) { E(acc, cur, wr, wc, fr, fq); S.done(cur); }
        PG8_STAMP();
        if (!has_next) break;
#pragma unroll
        for (int a = 0; a < 2; ++a)
#pragma unroll
            for (int b = 0; b < 2; ++b)
#pragma unroll
                for (int m = 0; m < 4; ++m)
#pragma unroll
                    for (int n = 0; n < 2; ++n) acc[a][b][m][n] = (f32x4){0.f, 0.f, 0.f, 0.f};
        cur = nxt; cA = nA; cB = nB; ++ui;
    }
    PG8_WAIT_V(0);
    if (wr == 0) PG8_BAR;
    PG8_BAR;
    if constexpr (Epi::AFTER_DRAIN) { E.fused(acc, cur, wr, wc, fr, fq, lds, wid, lane); S.done(cur); }
    PG8_STAMP();
    if (STAMP && wid == 0) { stamps[lane] = lane < nts ? (((unsigned long long)(unsigned)ts_hi << 32) | (unsigned)ts_lo) : 0ull;
        }
#undef PG8_STAMP
#undef PG8_SA
#undef PG8_SB
#undef PG8_STAGE
#undef PG8_LDA
#undef PG8_LDB
#undef PG8_MMA
#undef PG8_WAIT_V
#undef PG8_WAIT_L
#undef PG8_BAR
#undef PG8_SCHED
}
}

using pg8::bf16_t; using pg8::bf16x8; using pg8::f32x4; using pg8::u32x4;
typedef short s16x4 __attribute__((ext_vector_type(4)));
typedef unsigned u32x2 __attribute__((ext_vector_type(2)));
#define DI __device__ __forceinline__

constexpr int TC = 8192, TLAT = 4096, TT = 12288, DM = 1024, NLAY = 4;
constexpr int NIN = 6944, NZ = 7168, ZBW = 3072, GLW = 4096, FF = 2816;
constexpr int NKEY = 13312;
constexpr int NTHR = 512;
constexpr int LDS_MAIN = 131072, LDS_BYTES = LDS_MAIN + 1024;

constexpr size_t al256(size_t x) { return (x + 255) & ~(size_t)255; }
constexpr size_t WS_CTL = 0;
constexpr size_t WS_BAR = 4096;
constexpr size_t WS_MOD = 32768;
constexpr size_t WS_ROPE = WS_MOD + al256((size_t)4 * 3 * 6144 * 4);
constexpr size_t WS_W = WS_ROPE + al256((size_t)(1024 * 2 + 512 * 2) * 4);
constexpr size_t W_IN = WS_W;
constexpr size_t W_BR = W_IN + (size_t)NZ * DM * 2;
constexpr size_t W_O4 = W_BR + (size_t)4096 * 256 * 2;
constexpr size_t W_GU = W_O4 + (size_t)1024 * 4096 * 2;
constexpr size_t W_DN = W_GU + (size_t)5632 * 1024 * 2;
constexpr size_t W_UQ = W_DN + (size_t)1024 * FF * 2;
constexpr size_t W_UKV = W_UQ + (size_t)384 * 256 * 2;
constexpr size_t W_W2 = W_UKV + (size_t)512 * 128 * 2;
constexpr size_t W_A2 = W_W2 + (size_t)2 * 256 * 64 * 2;
constexpr size_t W_G2 = W_A2 + (size_t)2 * 256 * 64 * 2;
constexpr size_t WS_HYS = al256(W_G2 + (size_t)256 * 128 * 2);
constexpr size_t WS_ZB = WS_HYS + (size_t)TT * DM * 2;
constexpr size_t WS_GL = WS_ZB + (size_t)TT * ZBW * 2;
constexpr size_t WS_GP = WS_GL + (size_t)TT * GLW * 2;
constexpr size_t WS_MO = WS_GP + (size_t)TT * GLW * 2;
constexpr size_t WS_END = WS_MO + (size_t)TT * DM * 4;
constexpr size_t SZ_B = (size_t)TT * 256 * 2, SZ_F = (size_t)TT * 256 * 4;
constexpr size_t R_KK = WS_GP, R_KD0 = R_KK + SZ_B, R_KD1 = R_KD0 + SZ_B, R_B0 = R_KD1 + SZ_B, R_B1 = R_B0 + SZ_B;
constexpr size_t R_DEC0 = R_B1 + SZ_B, R_DEC1 = R_DEC0 + SZ_F, R_G = R_DEC1 + SZ_F, R_BS = R_G + SZ_B;
constexpr size_t R_Y0 = R_BS + al256((size_t)TT * 4 * 4), R_Y1 = R_Y0 + SZ_F;
constexpr size_t A_QM = R_Y1 + SZ_F;
constexpr size_t A_KM = A_QM + (size_t)TT * 384 * 2;
constexpr size_t A_VTM = A_KM + (size_t)4 * NKEY * 96 * 2;
constexpr size_t A_QG = A_VTM + (size_t)256 * NKEY * 2;
constexpr size_t A_KG = A_QG + (size_t)TT * 256 * 2;
constexpr size_t A_VTG = A_KG + (size_t)2 * NKEY * 64 * 2;
constexpr size_t A_KN = A_VTG + (size_t)128 * NKEY * 2;
constexpr size_t A_VTN = A_KN + (size_t)4 * NKEY * 64 * 2;
constexpr size_t A_END = A_VTN + (size_t)256 * NKEY * 2;
static_assert(A_END <= WS_END, "branch scratch overflows");

constexpr size_t O_X = 0, O_STATE = 12582912, O_CKV = 16777216, O_KPE = 20971520, O_GK = 22020096, O_GV = 26214400, O_NK = 30408704, O_NV = 38797312;

struct Params { const float* in[40]; float* out; unsigned char* ws; int ph_lo, ph_hi; };

DI float bf2f(bf16_t b) { return __uint_as_float(((unsigned)b) << 16); }
DI bf16_t f2bf(float f) { unsigned u = __float_as_uint(f); u += 0x7FFFu + ((u >> 16) & 1u); return (bf16_t)(u >> 16); }
DI unsigned pk2(float lo, float hi) { return (unsigned)f2bf(lo) | ((unsigned)f2bf(hi) << 16); }
DI float sigmoidf_(float x) { return __builtin_amdgcn_rcpf(1.0f + __expf(-x)); }
template <int CTRL> DI float dppf(float x) { return __int_as_float(__builtin_amdgcn_update_dpp(0, __float_as_int(x), CTRL, 0xf, 0xf, true)); }
DI float rowsum16(float x) { x += dppf<0x128>(x); x += dppf<0x124>(x); x += dppf<0x122>(x); x += dppf<0x121>(x); return x; }
DI float wavesum(float x) { for (int o = 32; o >= 1; o >>= 1) x += __shfl_xor(x, o); return x; }

struct EpiZ {
    static constexpr bool PERM = true, AFTER_DRAIN = false;
    bf16_t* zb; bf16_t* gl;
    DI void operator()(const f32x4 (&acc)[2][2][4][2], const pg8::Unit& u, int wr, int wc, int fr, int fq) const {
        const int row0 = u.pm * 256 + wr * 64 + fr; bf16_t* base; int ldc, colt;
        if (u.pn < 12) { base = zb; ldc = ZBW; colt = u.pn * 256; } else { base = gl; ldc = GLW; colt = (u.pn - 12) * 256; }
        const int col0 = colt + wc * 32 + 8 * fq;
#pragma unroll
        for (int ai = 0; ai < 2; ++ai)
#pragma unroll
            for (int m = 0; m < 4; ++m) { bf16_t* rowp = base + (size_t)(row0 + ai * 128 + m * 16) * ldc + col0;
#pragma unroll
                for (int bj = 0; bj < 2; ++bj) { const f32x4 v0 = acc[ai][bj][m][0], v1 = acc[ai][bj][m][1];
                    u32x4 w; w.x = pg8::cvt_pk_bf16(v0[0], v0[1]); w.y = pg8::cvt_pk_bf16(v0[2], v0[3]); w.z = pg8::cvt_pk_bf16(v1[0], v1[1]); w.w = pg8::cvt_pk_bf16(v1[2], v1[3]);
                    *(u32x4*)(rowp + bj * 128) = w; } }
    }
};
struct EpiGate {
    static constexpr bool PERM = true, AFTER_DRAIN = false;
    const bf16_t* gl; bf16_t* gp;
    DI void operator()(const f32x4 (&acc)[2][2][4][2], const pg8::Unit& u, int wr, int wc, int fr, int fq) const {
        const int row0 = u.pm * 256 + wr * 64 + fr; const int col0 = u.pn * 256 + wc * 32 + 8 * fq;
#pragma unroll
        for (int ai = 0; ai < 2; ++ai)
#pragma unroll
            for (int m = 0; m < 4; ++m) {
#pragma unroll
                for (int bj = 0; bj < 2; ++bj) { const size_t off = (size_t)(row0 + ai * 128 + m * 16) * GLW + col0 + bj * 128;
                    const u32x4 gw = *(const u32x4*)(gl + off); u32x4 w;
                    { const f32x4 v = acc[ai][bj][m][0];
                      w.x = pg8::cvt_pk_bf16(v[0] * sigmoidf_(__uint_as_float(gw.x << 16)), v[1] * sigmoidf_(__uint_as_float(gw.x & 0xffff0000u)));
                      w.y = pg8::cvt_pk_bf16(v[2] * sigmoidf_(__uint_as_float(gw.y << 16)), v[3] * sigmoidf_(__uint_as_float(gw.y & 0xffff0000u))); }
                    { const f32x4 v = acc[ai][bj][m][1];
                      w.z = pg8::cvt_pk_bf16(v[0] * sigmoidf_(__uint_as_float(gw.z << 16)), v[1] * sigmoidf_(__uint_as_float(gw.z & 0xffff0000u)));
                      w.w = pg8::cvt_pk_bf16(v[2] * sigmoidf_(__uint_as_float(gw.w << 16)), v[3] * sigmoidf_(__uint_as_float(gw.w & 0xffff0000u))); }
                    *(u32x4*)(gp + off) = w;
                    asm volatile("" ::: "memory"); } }
    }
};
struct EpiSwiGLU {
    static constexpr bool PERM = false, AFTER_DRAIN = false;
    bf16_t* act;
    DI void operator()(const f32x4 (&acc)[2][2][4][2], const pg8::Unit& u, int wr, int wc, int fr, int fq) const {
        const int row0 = u.pm * 256 + wr * 64 + fr; const int col0 = (u.pn * 256 + wc * 32) / 2 + 4 * fq;
#pragma unroll
        for (int ai = 0; ai < 2; ++ai)
#pragma unroll
            for (int m = 0; m < 4; ++m) { bf16_t* rowp = act + (size_t)(row0 + ai * 128 + m * 16) * FF + col0;
#pragma unroll
                for (int bj = 0; bj < 2; ++bj) { const f32x4 g = acc[ai][bj][m][0], up = acc[ai][bj][m][1];
                    u32x2 w; w.x = pg8::cvt_pk_bf16(g[0] * sigmoidf_(g[0]) * up[0], g[1] * sigmoidf_(g[1]) * up[1]);
                    w.y = pg8::cvt_pk_bf16(g[2] * sigmoidf_(g[2]) * up[2], g[3] * sigmoidf_(g[3]) * up[3]);
                    *(u32x2*)(rowp + bj * 64) = w; } }
    }
};

typedef const float* cfp_t;
typedef const cfp_t __attribute__((address_space(4)))* KIn;
struct Ctx {
    KIn in; float* out; unsigned char* ws; unsigned char* smem; int rep = 0;
    template <class T> DI T* w(size_t off) const { return (T*)(ws + off); }
};

DI void phase_mod(const Ctx& C) {
    const int tid = TIDX;
    float* sc = (float*)C.smem;
    float* red = sc + 3072;
    for (int i = tid; i < 3072; i += NTHR) { const int j = i >> 10, k = i & 1023; const float v = (j == 0) ? C.in[10][k] : C.in[2][(j - 1) * 1024 + k]; sc[i] = v * sigmoidf_(v); }
    __syncthreads();
    float* mod = C.w<float>(WS_MOD);
    for (int item = BIDX; item < 4 * 48; item += gridDim.x) {
        const int l = item / 48, cb = item % 48, col = cb * 128 + (tid & 127), kg = tid >> 7;
        const float* wp = C.in[11] + ((size_t)l * 1024 + kg * 256) * 6144 + col;
        float a0 = 0.f, a1 = 0.f, a2 = 0.f;
#pragma unroll 8
        for (int k = 0; k < 256; ++k) { const float w = wp[(size_t)k * 6144]; a0 += sc[kg * 256 + k] * w; a1 += sc[1024 + kg * 256 + k] * w; a2 += sc[2048 + kg * 256 + k] * w; }
        red[(kg * 3 + 0) * 128 + (tid & 127)] = a0; red[(kg * 3 + 1) * 128 + (tid & 127)] = a1; red[(kg * 3 + 2) * 128 + (tid & 127)] = a2;
        __syncthreads();
        if (tid < 384) { const int j = tid >> 7, c = tid & 127; const float s = red[(0 * 3 + j) * 128 + c] + red[(1 * 3 + j) * 128 + c] + red[(2 * 3 + j) * 128 + c] + red[(3 * 3 + j) * 128 + c];
            mod[((size_t)l * 3 + j) * 6144 + cb * 128 + c] = s + C.in[12][l * 6144 + cb * 128 + c]; }
        __syncthreads();
    }
    if (BIDX == gridDim.x - 1) {
        float* rp = C.w<float>(WS_ROPE);
        for (int i = tid; i < 1024; i += NTHR) { const int p = i >> 4, f = i & 15; const float inv = powf(10000.0f, -(float)f / 16.0f); const float a = (float)p * inv; rp[i] = cosf(a); rp[1024 + i] = sinf(a); }
        for (int i = tid; i < 512; i += NTHR) { const int p = i >> 3, f = i & 7; const float inv = powf(10000.0f, -(float)f / 8.0f); const float a = (float)p * inv; rp[2048 + i] = cosf(a); rp[2560 + i] = sinf(a); }
    }
}

DI void conv_job(const Ctx& C, const float* src, bf16_t* dst, int K, int N, int ld, int mode) {
    float* tile = (float*)C.smem;
    const int tid = TIDX, nk = K / 64, nn = (N + 63) / 64;
    for (int t = BIDX; t < nk * nn; t += gridDim.x) {
        const int k0 = (t % nk) * 64, n0 = (t / nk) * 64;
#pragma unroll
        for (int i = 0; i < 2; ++i) { const int k = (tid >> 4) + 32 * i, n4 = (tid & 15) * 4;
            f32x4 v = {0.f, 0.f, 0.f, 0.f}; if (n0 + n4 < N) v = *(const f32x4*)(src + (size_t)(k0 + k) * N + n0 + n4);
            tile[k * 65 + n4] = v[0]; tile[k * 65 + n4 + 1] = v[1]; tile[k * 65 + n4 + 2] = v[2]; tile[k * 65 + n4 + 3] = v[3]; }
        __syncthreads();
        { const int n = tid >> 3, k8 = (tid & 7) * 8, ng = n0 + n;
          if (ng < N) {
            u32x4 w; w.x = pk2(tile[(k8 + 0) * 65 + n], tile[(k8 + 1) * 65 + n]); w.y = pk2(tile[(k8 + 2) * 65 + n], tile[(k8 + 3) * 65 + n]);
            w.z = pk2(tile[(k8 + 4) * 65 + n], tile[(k8 + 5) * 65 + n]); w.w = pk2(tile[(k8 + 6) * 65 + n], tile[(k8 + 7) * 65 + n]);
            int row = ng;
            if (mode == 1) row = ng < 2848 ? ng : ng + 224;
            else if (mode == 3) row = (ng >> 4) * 32 + (ng & 15);
            else if (mode == 4) row = (ng >> 4) * 32 + 16 + (ng & 15);
            bf16_t* dp = dst + (size_t)row * ld + k0 + k8;
            *(u32x4*)dp = w;
            if (mode == 2) { *(u32x4*)(dp + 1024) = w; *(u32x4*)(dp + 2048) = w; *(u32x4*)(dp + 3072) = w; }
          } }
        __syncthreads();
    }
}
DI void phase_convert(const Ctx& C, int l) {
    { bf16_t* z = C.w<bf16_t>(W_IN) + (size_t)2848 * 1024;
      for (int i = BIDX * NTHR + TIDX; i < 224 * 1024 / 8; i += gridDim.x * NTHR) *(u32x4*)(z + (size_t)i * 8) = (u32x4){0u, 0u, 0u, 0u}; }
    conv_job(C, C.in[17] + (size_t)l * 1024 * NIN, C.w<bf16_t>(W_IN), 1024, NIN, 1024, 1);
    for (int n = 0; n < 4; ++n) conv_job(C, C.in[35] + ((size_t)l * 4 + n) * 256 * 1024, C.w<bf16_t>(W_BR) + (size_t)n * 1024 * 256, 256, 1024, 256, 0);
    conv_job(C, C.in[36] + (size_t)l * 1024 * 1024, C.w<bf16_t>(W_O4), 1024, 1024, 4096, 2);
    conv_job(C, C.in[37] + (size_t)l * 1024 * FF, C.w<bf16_t>(W_GU), 1024, FF, 1024, 3);
    conv_job(C, C.in[38] + (size_t)l * 1024 * FF, C.w<bf16_t>(W_GU), 1024, FF, 1024, 4);
    conv_job(C, C.in[39] + (size_t)l * FF * 1024, C.w<bf16_t>(W_DN), FF, 1024, FF, 0);
    conv_job(C, C.in[29] + (size_t)l * 256 * 384, C.w<bf16_t>(W_UQ), 256, 384, 256, 0);
    conv_job(C, C.in[31] + (size_t)l * 128 * 512, C.w<bf16_t>(W_UKV), 128, 512, 128, 0);
    for (int d = 0; d < 2; ++d) {
        conv_job(C, C.in[19] + ((size_t)l * 2 + d) * 64 * 256, C.w<bf16_t>(W_W2) + (size_t)d * 256 * 64, 64, 256, 64, 0);
        conv_job(C, C.in[21] + ((size_t)l * 2 + d) * 64 * 256, C.w<bf16_t>(W_A2) + (size_t)d * 256 * 64, 64, 256, 64, 0);
    }
    conv_job(C, C.in[22] + (size_t)l * 128 * 256, C.w<bf16_t>(W_G2), 128, 256, 128, 0);
}

DI void phase_rowprep(const Ctx& C, int mode, int l) {
    const int lane = TIDX & 63, wave = TIDX >> 6;
    const float* mod = C.w<float>(WS_MOD); const float* mo = C.w<float>(WS_MO); bf16_t* h = C.w<bf16_t>(WS_HYS);
    const int lh = (mode == 0) ? 0 : (mode == 1 ? l : (l + 1 < NLAY ? l + 1 : -1));
    const float* gpost = (mode == 1) ? C.in[14] + l * 1024 : C.in[16] + l * 1024;
    const float* gpre = (mode == 1) ? C.in[15] + l * 1024 : C.in[13] + (lh < 0 ? 0 : lh) * 1024;
    const int goff = (mode == 1) ? 2048 : 5120, shoff = (mode == 1) ? 3072 : 0, scoff = (mode == 1) ? 4096 : 1024;
    for (int t = BIDX * 8 + wave; t < TT; t += gridDim.x * 8) {
        const int j = t < TC ? 0 : 1 + (t - TC) / 2048;
        f32x4 x[4];
        if (mode == 0) { const float* src = t < TC ? C.in[0] + (size_t)t * 1024 : C.in[1] + (size_t)(t - TC) * 1024;
#pragma unroll
            for (int i = 0; i < 4; ++i) x[i] = *(const f32x4*)(src + i * 256 + lane * 4); }
        else {
            const float* mg = mod + ((size_t)l * 3 + j) * 6144 + goff;
            f32x4 y[4]; float ss = 0.f;
#pragma unroll
            for (int i = 0; i < 4; ++i) { y[i] = *(const f32x4*)(mo + (size_t)t * 1024 + i * 256 + lane * 4); x[i] = *(const f32x4*)(C.out + (size_t)t * 1024 + i * 256 + lane * 4); ss += y[i][0] * y[i][0] + y[i][1] * y[i][1] + y[i][2] * y[i][2] + y[i][3] * y[i][3]; }
            ss = wavesum(ss); const float rs = rsqrtf(ss * (1.0f / 1024.0f) + 1e-6f);
#pragma unroll
            for (int i = 0; i < 4; ++i) { const f32x4 gp = *(const f32x4*)(gpost + i * 256 + lane * 4), gt = *(const f32x4*)(mg + i * 256 + lane * 4); x[i] = x[i] + gt * (y[i] * rs * gp); }
        }
#pragma unroll
        for (int i = 0; i < 4; ++i) *(f32x4*)(C.out + (size_t)t * 1024 + i * 256 + lane * 4) = x[i];
        if (lh >= 0) {
            const float* mb = mod + ((size_t)lh * 3 + j) * 6144;
            float ss = 0.f;
#pragma unroll
            for (int i = 0; i < 4; ++i) ss += x[i][0] * x[i][0] + x[i][1] * x[i][1] + x[i][2] * x[i][2] + x[i][3] * x[i][3];
            ss = wavesum(ss); const float rs = rsqrtf(ss * (1.0f / 1024.0f) + 1e-6f);
#pragma unroll
            for (int i = 0; i < 4; ++i) { const f32x4 g = *(const f32x4*)(gpre + i * 256 + lane * 4), sc = *(const f32x4*)(mb + scoff + i * 256 + lane * 4), sh = *(const f32x4*)(mb + shoff + i * 256 + lane * 4);
                const f32x4 hv = (x[i] * rs * g) * (sc + 1.0f) + sh; u32x2 w; w.x = pk2(hv[0], hv[1]); w.y = pk2(hv[2], hv[3]);
                *(u32x2*)(h + (size_t)t * 1024 + i * 256 + lane * 4) = w; }
        }
    }
}

constexpr int ZT_LD = 2856;
template <int K> DI f32x4 tile_gemm(const bf16_t* zt, int acol, const bf16_t* Bt, int n0, int lane) {
    f32x4 acc = {0.f, 0.f, 0.f, 0.f}; const int r = lane & 15, q = lane >> 4;
    const bf16_t* ap = zt + r * ZT_LD + acol + q * 8; const bf16_t* bp = Bt + (size_t)(n0 + r) * K + q * 8;
#pragma unroll
    for (int ks = 0; ks < K / 32; ++ks) { const bf16x8 a = *(const bf16x8*)(ap + ks * 32); const bf16x8 b = *(const bf16x8*)(bp + ks * 32); acc = __builtin_amdgcn_mfma_f32_16x16x32_bf16(a, b, acc, 0, 0, 0); }
    return acc;
}
DI float red_xor(float v, int span) { for (int o = 1; o < span; o <<= 1) v += __shfl_xor(v, o); return v; }

DI void prep_tile(const Ctx& C, int l, int item) {
    bf16_t* ZT = (bf16_t*)C.smem; float* KKs = (float*)(C.smem + 91392); float* PART = (float*)(C.smem + 91392 + 16384);
    const int tid = TIDX, lane = tid & 63, wave = tid >> 6, r16 = lane & 15, quad = lane >> 4;
    const bool cached = item >= 768;
    int t0, kidx0, seq, pos0; bool latent;
    if (!cached) { t0 = item * 16; latent = t0 >= TC; if (!latent) { seq = t0 >> 8; pos0 = t0 & 255; kidx0 = t0; } else { const int u = t0 - TC; seq = 32 + (u >> 11); pos0 = u & 2047; kidx0 = TC + (u >> 11) * 2560 + pos0; } }
    else { const int ct = item - 768, b = ct >> 5; pos0 = (ct & 31) * 16; seq = 32 + b; kidx0 = TC + b * 2560 + 2048 + pos0; latent = true; t0 = 0; }
    const bf16_t* zb = C.w<bf16_t>(WS_ZB);
    if (!cached) {
        u32x4 tmp[12];
#pragma unroll
        for (int k = 0; k < 12; ++k) { const int i = tid + k * NTHR; if (i < 16 * 356) { const int row = i / 356, ch = i % 356; tmp[k] = *(const u32x4*)(zb + (size_t)(t0 + row) * ZBW + ch * 8); } }
#pragma unroll
        for (int k = 0; k < 12; ++k) { const int i = tid + k * NTHR; if (i < 16 * 356) { const int row = i / 356, ch = i % 356; *(u32x4*)(ZT + row * ZT_LD + ch * 8) = tmp[k]; } }
    } else {
        const int b = seq - 32; const size_t rb = ((size_t)b * 4 + l) * 512 + pos0;
        for (int i = tid; i < 16 * 928; i += NTHR) { const int row = i / 928, e = i % 928; float v; int col;
            if (e < 128) { v = C.in[4][(rb + row) * 128 + e]; col = 1408 + e; }
            else if (e < 160) { v = C.in[5][(rb + row) * 32 + (e - 128)]; col = 1536 + (e - 128); }
            else if (e < 288) { v = C.in[6][(rb + row) * 128 + (e - 160)]; col = 1824 + (e - 160); }
            else if (e < 416) { v = C.in[7][(rb + row) * 128 + (e - 288)]; col = 1952 + (e - 288); }
            else if (e < 672) { v = C.in[8][(rb + row) * 256 + (e - 416)]; col = 2336 + (e - 416); }
            else { v = C.in[9][(rb + row) * 256 + (e - 672)]; col = 2592 + (e - 672); }
            ZT[row * ZT_LD + col] = f2bf(v); }
    }
    __syncthreads();
    const float* PV = (const float*)(C.smem + 108800); const float* rope = PV + 2304;
    if (!cached) {
        const int tok = tid >> 5, sub = tid & 31, t = t0 + tok, pos = pos0 + tok; bf16_t* zr = ZT + tok * ZT_LD;
        const size_t crow = ((size_t)seq * 4 + l) * 256 + pos;
#pragma unroll
        for (int i = 0; i < 4; ++i) { const int c = sub * 4 + i; zr[768 + c] = f2bf(tanhf(bf2f(zr[768 + c]))); zr[1024 + c] = f2bf(sigmoidf_(bf2f(zr[1024 + c]))); }
        { float x[8]; float ss = 0.f;
#pragma unroll
          for (int i = 0; i < 8; ++i) { x[i] = bf2f(zr[1152 + sub * 8 + i]); ss += x[i] * x[i]; }
          ss = red_xor(ss, 32); const float rs = rsqrtf(ss * (1.0f / 256.0f) + 1e-6f);
#pragma unroll
          for (int i = 0; i < 8; ++i) zr[1152 + sub * 8 + i] = f2bf(x[i] * rs * PV[0 + sub * 8 + i]); }
        { float x[4]; float ss = 0.f;
#pragma unroll
          for (int i = 0; i < 4; ++i) { x[i] = bf2f(zr[1408 + sub * 4 + i]); ss += x[i] * x[i]; }
          ss = red_xor(ss, 32); const float rs = rsqrtf(ss * (1.0f / 128.0f) + 1e-6f);
#pragma unroll
          for (int i = 0; i < 4; ++i) { const float y = x[i] * rs * PV[256 + sub * 4 + i]; zr[1408 + sub * 4 + i] = f2bf(y); if (!latent) C.out[O_CKV + crow * 128 + sub * 4 + i] = y; } }
        { float x[8]; float ss = 0.f;
#pragma unroll
          for (int i = 0; i < 8; ++i) { x[i] = bf2f(zr[256 + sub * 8 + i]) * PV[384 + sub * 8 + i]; ss += x[i] * x[i]; }
          ss = red_xor(ss, 8); const float rs = rsqrtf(ss + 1e-12f);
          bf16_t* kkg = C.w<bf16_t>(R_KK) + (size_t)t * 256 + sub * 8;
#pragma unroll
          for (int i = 0; i < 8; ++i) { const float y = x[i] * rs; KKs[tok * 256 + sub * 8 + i] = y; kkg[i] = f2bf(y); } }
        { float x[8]; float ss = 0.f;
#pragma unroll
          for (int i = 0; i < 8; ++i) { x[i] = bf2f(zr[1568 + sub * 8 + i]); ss += x[i] * x[i]; }
          ss = red_xor(ss, 8); const float rs = rsqrtf(ss * (1.0f / 64.0f) + 1e-6f);
#pragma unroll
          for (int i = 0; i < 8; ++i) zr[1568 + sub * 8 + i] = f2bf(x[i] * rs * PV[640 + (sub & 7) * 8 + i]); }
        { float x[4]; float ss = 0.f;
#pragma unroll
          for (int i = 0; i < 4; ++i) { x[i] = bf2f(zr[1824 + sub * 4 + i]); ss += x[i] * x[i]; }
          ss = red_xor(ss, 16); const float rs = rsqrtf(ss * (1.0f / 64.0f) + 1e-6f);
#pragma unroll
          for (int i = 0; i < 4; ++i) { const float y = x[i] * rs * PV[704 + (sub & 15) * 4 + i]; zr[1824 + sub * 4 + i] = f2bf(y); if (!latent) C.out[O_GK + crow * 128 + sub * 4 + i] = y; } }
        if (!latent) {
            C.out[O_KPE + crow * 32 + sub] = bf2f(zr[1536 + sub]);
#pragma unroll
            for (int i = 0; i < 4; ++i) C.out[O_GV + crow * 128 + sub * 4 + i] = bf2f(zr[1952 + sub * 4 + i]);
#pragma unroll
            for (int i = 0; i < 8; ++i) { C.out[O_NK + crow * 256 + sub * 8 + i] = bf2f(zr[2336 + sub * 8 + i]); C.out[O_NV + crow * 256 + sub * 8 + i] = bf2f(zr[2592 + sub * 8 + i]); }
        }
        __syncthreads();
        if (latent) {
            if (tid < 256) { const int tk = tid >> 4, i = tid & 15, p = pos0 + tk, pi = (i < 8) ? (p >> 6) : (p & 63), f = i & 7;
                const float cs = rope[2048 + pi * 8 + f], sn = rope[2560 + pi * 8 + f]; bf16_t* z = ZT + tk * ZT_LD + 1536;
                const float x1 = bf2f(z[i]), x2 = bf2f(z[16 + i]); z[i] = f2bf(x1 * cs - x2 * sn); z[16 + i] = f2bf(x1 * sn + x2 * cs); }
            for (int e = tid; e < 16 * 6 * 32; e += NTHR) { const int tk = e / 192, r = e % 192, hd = r >> 5, i = r & 31, p = pos0 + tk, pi = (i < 16) ? (p >> 6) : (p & 63), f = i & 15;
                const float cs = rope[pi * 16 + f], sn = rope[1024 + pi * 16 + f]; bf16_t* z = ZT + tk * ZT_LD + (hd < 4 ? 1568 + hd * 64 : 1824 + (hd - 4) * 64);
                const float x1 = bf2f(z[i]), x2 = bf2f(z[32 + i]); z[i] = f2bf(x1 * cs - x2 * sn); z[32 + i] = f2bf(x1 * sn + x2 * cs); }
            __syncthreads();
        }
    }
    if (tid < 256) { const int tk = tid >> 4, hd = (tid >> 2) & 3, ch = tid & 3;
        *(u32x4*)(C.w<bf16_t>(A_KM) + ((size_t)hd * NKEY + kidx0 + tk) * 96 + 64 + ch * 8) = *(const u32x4*)(ZT + tk * ZT_LD + 1536 + ch * 8); }
    if (!cached) { const int tk = tid >> 5, ch = tid & 31; *(u32x4*)(C.w<bf16_t>(A_QG) + (size_t)(t0 + tk) * 256 + ch * 8) = *(const u32x4*)(ZT + tk * ZT_LD + 1568 + ch * 8); }
    if (tid < 256) { const int tk = tid >> 4, hd = (tid >> 3) & 1, ch = tid & 7;
        *(u32x4*)(C.w<bf16_t>(A_KG) + ((size_t)hd * NKEY + kidx0 + tk) * 64 + ch * 8) = *(const u32x4*)(ZT + tk * ZT_LD + 1824 + hd * 64 + ch * 8); }
    { const int tk = tid >> 5, hd = (tid >> 3) & 3, ch = tid & 7;
        *(u32x4*)(C.w<bf16_t>(A_KN) + ((size_t)hd * NKEY + kidx0 + tk) * 64 + ch * 8) = *(const u32x4*)(ZT + tk * ZT_LD + 2336 + hd * 64 + ch * 8); }
    { const int col = tid >> 2, tg = tid & 3; const bf16_t* z = ZT + (tg * 4) * ZT_LD + 1952 + col;
        u32x2 w; w.x = (unsigned)z[0] | ((unsigned)z[ZT_LD] << 16); w.y = (unsigned)z[2 * ZT_LD] | ((unsigned)z[3 * ZT_LD] << 16);
        *(u32x2*)(C.w<bf16_t>(A_VTG) + (size_t)col * NKEY + kidx0 + tg * 4) = w; }
#pragma unroll
    for (int rep = 0; rep < 2; ++rep) { const int it = tid + rep * NTHR, col = it >> 2, tg = it & 3; const bf16_t* z = ZT + (tg * 4) * ZT_LD + 2592 + col;
        u32x2 w; w.x = (unsigned)z[0] | ((unsigned)z[ZT_LD] << 16); w.y = (unsigned)z[2 * ZT_LD] | ((unsigned)z[3 * ZT_LD] << 16);
        *(u32x2*)(C.w<bf16_t>(A_VTN) + (size_t)col * NKEY + kidx0 + tg * 4) = w; }
    f32x4 kva[4];
#pragma unroll
    for (int i = 0; i < 4; ++i) kva[i] = tile_gemm<128>(ZT, 1408, C.w<bf16_t>(W_UKV), (wave * 4 + i) * 16, lane);
    if (cached) {
#pragma unroll
        for (int i = 0; i < 4; ++i) { const int nt = wave * 4 + i, hd = nt >> 3, sb = nt & 7; const f32x4 acc = kva[i];
            if (sb < 4) { bf16_t* kp = C.w<bf16_t>(A_KM) + ((size_t)hd * NKEY + kidx0 + quad * 4) * 96 + sb * 16 + r16;
#pragma unroll
                for (int j = 0; j < 4; ++j) kp[j * 96] = f2bf(acc[j]); }
            else { u32x2 w; w.x = pk2(acc[0], acc[1]); w.y = pk2(acc[2], acc[3]);
                *(u32x2*)(C.w<bf16_t>(A_VTM) + ((size_t)hd * 64 + (sb - 4) * 16 + r16) * NKEY + kidx0 + quad * 4) = w; } }
    } else {
        const int dW = wave >> 2, hdq = wave >> 1, tbq = (wave & 1) * 3;
        f32x4 wa[4], aa0[2], aa1[2], ga[2], qa0, qa1, qa2;
#pragma unroll
        for (int i = 0; i < 4; ++i) wa[i] = tile_gemm<64>(ZT, 768 + dW * 64, C.w<bf16_t>(W_W2) + (size_t)dW * 256 * 64, ((wave & 3) * 4 + i) * 16, lane);
#pragma unroll
        for (int i = 0; i < 2; ++i) { aa0[i] = tile_gemm<64>(ZT, 896, C.w<bf16_t>(W_A2), (wave * 2 + i) * 16, lane); aa1[i] = tile_gemm<64>(ZT, 960, C.w<bf16_t>(W_A2) + (size_t)256 * 64, (wave * 2 + i) * 16, lane);
            ga[i] = tile_gemm<128>(ZT, 1024, C.w<bf16_t>(W_G2), (wave * 2 + i) * 16, lane); }
        qa0 = tile_gemm<256>(ZT, 1152, C.w<bf16_t>(W_UQ), hdq * 96 + (tbq + 0) * 16, lane);
        qa1 = tile_gemm<256>(ZT, 1152, C.w<bf16_t>(W_UQ), hdq * 96 + (tbq + 1) * 16, lane);
        qa2 = tile_gemm<256>(ZT, 1152, C.w<bf16_t>(W_UQ), hdq * 96 + (tbq + 2) * 16, lane);
#pragma unroll
        for (int i = 0; i < 4; ++i) { const int nt = wave * 4 + i, hd = nt >> 3, sb = nt & 7; const f32x4 acc = kva[i];
            if (sb < 4) { bf16_t* kp = C.w<bf16_t>(A_KM) + ((size_t)hd * NKEY + kidx0 + quad * 4) * 96 + sb * 16 + r16;
#pragma unroll
                for (int j = 0; j < 4; ++j) kp[j * 96] = f2bf(acc[j]); }
            else { u32x2 w; w.x = pk2(acc[0], acc[1]); w.y = pk2(acc[2], acc[3]);
                *(u32x2*)(C.w<bf16_t>(A_VTM) + ((size_t)hd * 64 + (sb - 4) * 16 + r16) * NKEY + kidx0 + quad * 4) = w; } }
        { float* dec = C.w<float>(dW ? R_DEC1 : R_DEC0);
#pragma unroll
            for (int i = 0; i < 4; ++i) { const int nt = (wave & 3) * 4 + i, c = nt * 16 + r16; const f32x4 acc = wa[i];
                const float w0 = PV[768 + dW * 256 + c];
#pragma unroll
                for (int j = 0; j < 4; ++j) { const float x = -(w0 + acc[j]); const float sp = fmaxf(x, 0.f) + __logf(1.0f + __expf(-fabsf(x))); const float w = -sp - 0.5f;
                    dec[(size_t)(t0 + quad * 4 + j) * 256 + c] = __expf(-__expf(w)); } } }
#pragma unroll
        for (int i = 0; i < 2; ++i) { const int nt = wave * 2 + i, c = nt * 16 + r16; const f32x4 ac0 = aa0[i], ac1 = aa1[i];
            const float a00 = PV[1280 + c], a01 = PV[1536 + c], ka = PV[1792 + c], rk = PV[2048 + c];
#pragma unroll
            for (int j = 0; j < 4; ++j) { const int tk = quad * 4 + j; const size_t o = (size_t)(t0 + tk) * 256 + c;
                const float a0 = sigmoidf_(a00 + ac0[j]), a1 = sigmoidf_(a01 + ac1[j]);
                const float k = bf2f(ZT[tk * ZT_LD + 256 + c]), r = bf2f(ZT[tk * ZT_LD + c]), kk = KKs[tk * 256 + c];
                const float kd0 = k * (1.0f + (a0 - 1.0f) * ka), kd1 = k * (1.0f + (a1 - 1.0f) * ka);
                C.w<bf16_t>(R_KD0)[o] = f2bf(kd0); C.w<bf16_t>(R_KD1)[o] = f2bf(kd1); C.w<bf16_t>(R_B0)[o] = f2bf(kk * a0); C.w<bf16_t>(R_B1)[o] = f2bf(kk * a1);
                const float part = rowsum16(r * 0.5f * (kd0 + kd1) * rk);
                if (r16 == 0) PART[tk * 16 + nt] = part; }
#pragma unroll
            for (int j = 0; j < 4; ++j) C.w<bf16_t>(R_G)[(size_t)(t0 + quad * 4 + j) * 256 + c] = f2bf(ga[i][j]); }
        { bf16_t* qm = C.w<bf16_t>(A_QM);
            if (latent && (wave & 1)) {
#pragma unroll
                for (int j = 0; j < 4; ++j) { const int p = pos0 + quad * 4 + j, pi = (r16 < 8) ? (p >> 6) : (p & 63), f = r16 & 7;
                    const float cs = rope[2048 + pi * 8 + f], sn = rope[2560 + pi * 8 + f]; const float x1 = qa1[j], x2 = qa2[j]; qa1[j] = x1 * cs - x2 * sn; qa2[j] = x1 * sn + x2 * cs; }
            }
#pragma unroll
            for (int j = 0; j < 4; ++j) { bf16_t* qp = qm + (size_t)(t0 + quad * 4 + j) * 384 + hdq * 96 + tbq * 16 + r16; qp[0] = f2bf(qa0[j]); qp[16] = f2bf(qa1[j]); qp[32] = f2bf(qa2[j]); } }
        __syncthreads();
        if (tid < 64) { const int tk = tid >> 2, hd = tid & 3; C.w<float>(R_BS)[(size_t)(t0 + tk) * 4 + hd] = PART[tk * 16 + hd * 4] + PART[tk * 16 + hd * 4 + 1] + PART[tk * 16 + hd * 4 + 2] + PART[tk * 16 + hd * 4 + 3]; }
    }
    __syncthreads();
}
DI void phase_prep(const Ctx& C, int l) {
    {
        float* PV = (float*)(C.smem + 108800); const int tid = TIDX;
        for (int i = tid; i < 5376; i += NTHR) { float v;
            if (i < 256) v = C.in[28][l * 256 + i]; else if (i < 384) v = C.in[30][l * 128 + i - 256]; else if (i < 640) v = C.in[23][l * 256 + i - 384];
            else if (i < 704) v = C.in[32][l * 64 + i - 640]; else if (i < 768) v = C.in[33][l * 64 + i - 704]; else if (i < 1280) v = C.in[18][l * 512 + i - 768];
            else if (i < 1792) v = C.in[20][l * 512 + i - 1280]; else if (i < 2048) v = C.in[24][l * 256 + i - 1792]; else if (i < 2304) v = C.in[25][l * 256 + i - 2048];
            else v = C.w<float>(WS_ROPE)[i - 2304];
            PV[i] = v; }
        __syncthreads();
    }
    for (int item = BIDX; item < 832; item += gridDim.x) prep_tile(C, l, item);
}

constexpr int ST_FLOATS = 5 * 32 * 64 + 32 * 16;
DI void scan_fill(const Ctx& C, float* st, int d, int tb, int n, int h, int g, int c, int i) {
    const int step = i >> 3, part = i & 7; const int s = c * 32 + step; const int tok = d ? tb + n - 1 - s : tb + s;
    const bf16_t* zb = C.w<bf16_t>(WS_ZB) + (size_t)tok * ZBW; const size_t o = (size_t)tok * 256 + h * 64 + part * 8;
    const u32x4 rr = *(const u32x4*)(zb + h * 64 + part * 8);
    const f32x4 w0 = *(const f32x4*)(C.w<float>(d ? R_DEC1 : R_DEC0) + o), w1 = *(const f32x4*)(C.w<float>(d ? R_DEC1 : R_DEC0) + o + 4);
    const u32x4 kd = *(const u32x4*)(C.w<bf16_t>(d ? R_KD1 : R_KD0) + o), kk = *(const u32x4*)(C.w<bf16_t>(R_KK) + o), bb = *(const u32x4*)(C.w<bf16_t>(d ? R_B1 : R_B0) + o);
    u32x4 vv = {0u, 0u, 0u, 0u}; if (part < 2) vv = *(const u32x4*)(zb + 512 + h * 64 + g * 16 + part * 8);
    float* p = st + step * 64 + part * 8;
#define EXP8(dst, u) do { *(f32x4*)(dst) = (f32x4){__uint_as_float((u).x << 16), __uint_as_float((u).x & 0xffff0000u), __uint_as_float((u).y << 16), __uint_as_float((u).y & 0xffff0000u)}; \
        *(f32x4*)((dst) + 4) = (f32x4){__uint_as_float((u).z << 16), __uint_as_float((u).z & 0xffff0000u), __uint_as_float((u).w << 16), __uint_as_float((u).w & 0xffff0000u)}; } while (0)
    EXP8(p, rr); *(f32x4*)(p + 2048) = w0; *(f32x4*)(p + 2048 + 4) = w1; EXP8(p + 4096, kd); EXP8(p + 6144, kk); EXP8(p + 8192, bb);
    if (part < 2) { float* pv = st + 10240 + step * 16 + part * 8; EXP8(pv, vv); }
#undef EXP8
}
typedef float f32x2 __attribute__((ext_vector_type(2)));
DI void scan_item(const Ctx& C, int l, int d, int seq, int h, int g) {
    const int tid = TIDX; const bool latent = seq >= 32;
    const int n = latent ? 2048 : 256, tb = latent ? TC + (seq - 32) * 2048 : seq * 256, nch = n / 32;
    float* buf = (float*)C.smem;
    const bool stager = tid >= 256; const int i = tid & 255, row = i >> 4, cgp = i & 15;
    f32x2 S01 = {0.f, 0.f}, S23 = {0.f, 0.f};
    if (!stager && latent) { const f32x4 s4 = *(const f32x4*)(C.in[3] + (((((size_t)(seq - 32) * 4 + l) * 2 + d) * 4 + h) * 64 + g * 16 + row) * 64 + cgp * 4); S01 = (f32x2){s4[0], s4[1]}; S23 = (f32x2){s4[2], s4[3]}; }
    float* yout = C.w<float>(d ? R_Y1 : R_Y0) + h * 64 + g * 16 + row;
    if (stager) scan_fill(C, buf, d, tb, n, h, g, 0, i);
    __syncthreads();
    for (int c = 0; c < nch; ++c) {
        const float* st = buf + (c & 1) * ST_FLOATS;
        if (stager) { if (c + 1 < nch) scan_fill(C, buf + ((c + 1) & 1) * ST_FLOATS, d, tb, n, h, g, c + 1, i); }
        else {
            const float* p = st + cgp * 4; const float* pv = st + 10240 + row;
            f32x4 r4 = *(const f32x4*)(p), w4 = *(const f32x4*)(p + 2048), k4 = *(const f32x4*)(p + 4096), q4 = *(const f32x4*)(p + 6144), b4 = *(const f32x4*)(p + 8192); float v = pv[0];
#pragma unroll
            for (int hs = 0; hs < 2; ++hs) {
                float yk = 0.f, dyp = 0.f;
#pragma unroll
                for (int ss = 0; ss < 16; ++ss) {
                    const int s = hs * 16 + ss, sn = s + 1 < 32 ? s + 1 : 31;
                    const f32x4 nr = *(const f32x4*)(p + sn * 64), nw = *(const f32x4*)(p + 2048 + sn * 64), nk = *(const f32x4*)(p + 4096 + sn * 64), nq = *(const f32x4*)(p + 6144 + sn * 64), nb = *(const f32x4*)(p + 8192 + sn * 64);
                    const float nv = pv[sn * 16];
                    __builtin_amdgcn_sched_barrier(0);
                    const f32x2 dq = S01 * (f32x2){q4[0], q4[1]} + S23 * (f32x2){q4[2], q4[3]};
                    const f32x2 t01 = S01 * (f32x2){w4[0], w4[1]} + (f32x2){k4[0], k4[1]} * v, t23 = S23 * (f32x2){w4[2], w4[3]} + (f32x2){k4[2], k4[3]} * v;
                    float sa = dq[0] + dq[1], yp = dyp;
                    sa += dppf<0x128>(sa); yp += dppf<0x128>(yp); sa += dppf<0x124>(sa); yp += dppf<0x124>(yp);
                    sa += dppf<0x122>(sa); yp += dppf<0x122>(yp); sa += dppf<0x121>(sa); yp += dppf<0x121>(yp);
                    if (ss > 0) yk = (cgp == ss - 1) ? yp : yk;
                    S01 = t01 - (f32x2){b4[0], b4[1]} * sa; S23 = t23 - (f32x2){b4[2], b4[3]} * sa;
                    const f32x2 dy = S01 * (f32x2){r4[0], r4[1]} + S23 * (f32x2){r4[2], r4[3]};
                    dyp = dy[0] + dy[1];
                    __builtin_amdgcn_sched_barrier(0);
                    r4 = nr; w4 = nw; k4 = nk; q4 = nq; b4 = nb; v = nv;
                }
                { const float yl = rowsum16(dyp); yk = (cgp == 15) ? yl : yk; }
                const int sg = c * 32 + hs * 16 + cgp; const int tok = d ? tb + n - 1 - sg : tb + sg;
                yout[(size_t)tok * 256] = yk;
            }
        }
        __syncthreads();
    }
    if (!stager && !latent) *(f32x4*)(C.out + O_STATE + (((((size_t)seq * 4 + l) * 2 + d) * 4 + h) * 64 + g * 16 + row) * 64 + cgp * 4) = (f32x4){S01[0], S01[1], S23[0], S23[1]};
}

DI float xq_max(float x) { auto r = __builtin_amdgcn_permlane16_swap(__float_as_uint(x), __float_as_uint(x), false, false); x = fmaxf(__uint_as_float(r[0]), __uint_as_float(r[1]));
    auto r2 = __builtin_amdgcn_permlane32_swap(__float_as_uint(x), __float_as_uint(x), false, false); return fmaxf(__uint_as_float(r2[0]), __uint_as_float(r2[1])); }
DI float xq_sum(float x) { auto r = __builtin_amdgcn_permlane16_swap(__float_as_uint(x), __float_as_uint(x), false, false); x = __uint_as_float(r[0]) + __uint_as_float(r[1]);
    auto r2 = __builtin_amdgcn_permlane32_swap(__float_as_uint(x), __float_as_uint(x), false, false); return __uint_as_float(r2[0]) + __uint_as_float(r2[1]); }
struct AttnSt { f32x4 o0, o1, o2, o3; float m, l; };
template <int DK, bool NA>
DI void attn_step(AttnSt& A, const bf16x8 (&kf)[2 * (DK / 32)], const s16x4 (&vf)[8], const bf16x8 (&qf)[DK / 32], float sl2, const float* rb, int dr, int c, int cstart, int quad) {
    f32x4 st0 = {0.f, 0.f, 0.f, 0.f}, st1 = st0;
#pragma unroll
    for (int ks = 0; ks < DK / 32; ++ks) { st0 = __builtin_amdgcn_mfma_f32_16x16x32_bf16(kf[2 * ks], qf[ks], st0, 0, 0, 0); st1 = __builtin_amdgcn_mfma_f32_16x16x32_bf16(kf[2 * ks + 1], qf[ks], st1, 0, 0, 0); }
    float s[8];
#pragma unroll
    for (int j = 0; j < 4; ++j) { s[j] = st0[j] * sl2; s[4 + j] = st1[j] * sl2; }
    if (NA) {
        int c0 = c - 8; c0 = c0 < 0 ? 0 : (c0 > 48 ? 48 : c0);
#pragma unroll
        for (int j = 0; j < 8; ++j) { const int kc = cstart + (j >> 2) * 16 + quad * 4 + (j & 3); const bool ok = (kc >= c0) && (kc < c0 + 16);
            int dc = kc - c + 15; dc = dc < 0 ? 0 : (dc > 30 ? 30 : dc);
            s[j] = ok ? s[j] + rb[dr * 31 + dc] * 1.44269504f : -INFINITY; }
    }
    float mx = fmaxf(fmaxf(fmaxf(s[0], s[1]), fmaxf(s[2], s[3])), fmaxf(fmaxf(s[4], s[5]), fmaxf(s[6], s[7])));
    mx = xq_max(mx);
    const float mn = fmaxf(A.m, mx), alpha = __builtin_amdgcn_exp2f(A.m - mn); A.m = mn;
    float ps = 0.f;
#pragma unroll
    for (int j = 0; j < 8; ++j) { s[j] = __builtin_amdgcn_exp2f(s[j] - mn); ps += s[j]; }
    A.l = A.l * alpha + ps;
    A.o0 *= alpha; A.o1 *= alpha; A.o2 *= alpha; A.o3 *= alpha;
    u32x4 pw; pw.x = pg8::cvt_pk_bf16(s[0], s[1]); pw.y = pg8::cvt_pk_bf16(s[2], s[3]); pw.z = pg8::cvt_pk_bf16(s[4], s[5]); pw.w = pg8::cvt_pk_bf16(s[6], s[7]);
    const bf16x8 pf = __builtin_bit_cast(bf16x8, pw);
    A.o0 = __builtin_amdgcn_mfma_f32_16x16x32_bf16(__builtin_shufflevector(vf[0], vf[1], 0, 1, 2, 3, 4, 5, 6, 7), pf, A.o0, 0, 0, 0);
    A.o1 = __builtin_amdgcn_mfma_f32_16x16x32_bf16(__builtin_shufflevector(vf[2], vf[3], 0, 1, 2, 3, 4, 5, 6, 7), pf, A.o1, 0, 0, 0);
    A.o2 = __builtin_amdgcn_mfma_f32_16x16x32_bf16(__builtin_shufflevector(vf[4], vf[5], 0, 1, 2, 3, 4, 5, 6, 7), pf, A.o2, 0, 0, 0);
    A.o3 = __builtin_amdgcn_mfma_f32_16x16x32_bf16(__builtin_shufflevector(vf[6], vf[7], 0, 1, 2, 3, 4, 5, 6, 7), pf, A.o3, 0, 0, 0);
}
DI void attn_store(const AttnSt& A, bf16_t* op) {
    const float inv = 1.0f / xq_sum(A.l);
    { u32x2 w; w.x = pk2(A.o0[0] * inv, A.o0[1] * inv); w.y = pk2(A.o0[2] * inv, A.o0[3] * inv); *(u32x2*)(op) = w; }
    { u32x2 w; w.x = pk2(A.o1[0] * inv, A.o1[1] * inv); w.y = pk2(A.o1[2] * inv, A.o1[3] * inv); *(u32x2*)(op + 16) = w; }
    { u32x2 w; w.x = pk2(A.o2[0] * inv, A.o2[1] * inv); w.y = pk2(A.o2[2] * inv, A.o2[3] * inv); *(u32x2*)(op + 32) = w; }
    { u32x2 w; w.x = pk2(A.o3[0] * inv, A.o3[1] * inv); w.y = pk2(A.o3[2] * inv, A.o3[3] * inv); *(u32x2*)(op + 48) = w; }
}
constexpr int ATT_VLD = 72, ATT_BUF = 64 * 104 * 2 + 64 * ATT_VLD * 2;
template <int DK, bool NA>
DI void attn_block(const Ctx& C, const bf16_t* Qw, int qs, const bf16_t* Kd, const bf16_t* Vd, int nsb, float scale, bf16_t* Ow,
                   const bf16_t* Kwin, const bf16_t* Vwin, const float* rb, int qr, int r0, int qcolw) {
    constexpr int KLD = DK + 8, KCH = DK / 8;
    const int tid = TIDX, lane = tid & 63, r16 = lane & 15, quad = lane >> 4;
    unsigned char* sm = C.smem;
    bf16x8 qf0[DK / 32], qf1[DK / 32];
#pragma unroll
    for (int ks = 0; ks < DK / 32; ++ks) { qf0[ks] = *(const bf16x8*)(Qw + (size_t)r16 * qs + ks * 32 + quad * 8); qf1[ks] = *(const bf16x8*)(Qw + (size_t)(16 + r16) * qs + ks * 32 + quad * 8); }
    const f32x4 z4 = {0.f, 0.f, 0.f, 0.f};
    AttnSt A0{z4, z4, z4, z4, -1e30f, 0.f}, A1 = A0;
    const float sl2 = scale * 1.44269504f;
    const int kc0 = tid, kc1 = tid + NTHR; const bool has1 = kc1 < 64 * KCH;
    const int vdv = tid >> 3, vpt = tid & 7;
    u32x4 gk0, gk1 = {0u, 0u, 0u, 0u}, gv;
#define ATT_GLOAD(sb) do { const bf16_t* kb_ = Kd + (size_t)(sb) * 64 * DK; gk0 = *(const u32x4*)(kb_ + (size_t)kc0 * 8); if (has1) gk1 = *(const u32x4*)(kb_ + (size_t)kc1 * 8); \
        gv = *(const u32x4*)(Vd + (size_t)vdv * NKEY + (size_t)(sb) * 64 + vpt * 8); } while (0)
#define ATT_LWRITE(buf) do { bf16_t* ks_ = (bf16_t*)(sm + (buf) * ATT_BUF); bf16_t* vs_ = ks_ + 64 * 104; *(u32x4*)(ks_ + (kc0 / KCH) * KLD + (kc0 % KCH) * 8) = gk0; \
        if (has1) *(u32x4*)(ks_ + (kc1 / KCH) * KLD + (kc1 % KCH) * 8) = gk1; *(u32x4*)(vs_ + vdv * ATT_VLD + vpt * 8) = gv; } while (0)
    ATT_GLOAD(0); ATT_LWRITE(0);
    __syncthreads();
    if (NA) {
#pragma unroll
        for (int qt = 0; qt < 2; ++qt) {
            const int qcol = qcolw + qt * 16; int cs = qcol - 8; cs = cs < 0 ? 0 : (cs > 32 ? 32 : cs);
            for (int wr = 0; wr < 8; ++wr) {
                const bf16_t* kp = Kwin + ((size_t)(wr * 64 + cs) + r16) * DK + quad * 8; const bf16_t* vp = Vwin + (size_t)r16 * NKEY + wr * 64 + cs + quad * 4;
                bf16x8 kf[2 * (DK / 32)]; s16x4 vf[8];
#pragma unroll
                for (int ks = 0; ks < DK / 32; ++ks) { kf[2 * ks] = *(const bf16x8*)(kp + ks * 32); kf[2 * ks + 1] = *(const bf16x8*)(kp + 16 * DK + ks * 32); }
#pragma unroll
                for (int dt = 0; dt < 4; ++dt) { vf[2 * dt] = *(const s16x4*)(vp + (size_t)dt * 16 * NKEY); vf[2 * dt + 1] = *(const s16x4*)(vp + (size_t)dt * 16 * NKEY + 16); }
                if (qt == 0) attn_step<DK, true>(A0, kf, vf, qf0, sl2, rb, r0 + wr - qr + 7, qcol + r16, cs, quad);
                else attn_step<DK, true>(A1, kf, vf, qf1, sl2, rb, r0 + wr - qr + 7, qcol + r16, cs, quad);
            }
        }
    }
    for (int sb = 0; sb < nsb; ++sb) {
        if (sb + 1 < nsb) ATT_GLOAD(sb + 1);
        const bf16_t* ks_ = (const bf16_t*)(sm + (sb & 1) * ATT_BUF); const bf16_t* vs_ = ks_ + 64 * 104;
#pragma unroll
        for (int hb = 0; hb < 2; ++hb) {
            bf16x8 kf[2 * (DK / 32)]; s16x4 vf[8];
#pragma unroll
            for (int ks = 0; ks < DK / 32; ++ks) { kf[2 * ks] = *(const bf16x8*)(ks_ + (hb * 32 + r16) * KLD + ks * 32 + quad * 8); kf[2 * ks + 1] = *(const bf16x8*)(ks_ + (hb * 32 + 16 + r16) * KLD + ks * 32 + quad * 8); }
#pragma unroll
            for (int dt = 0; dt < 4; ++dt) { vf[2 * dt] = *(const s16x4*)(vs_ + (dt * 16 + r16) * ATT_VLD + hb * 32 + quad * 4); vf[2 * dt + 1] = *(const s16x4*)(vs_ + (dt * 16 + r16) * ATT_VLD + hb * 32 + 16 + quad * 4); }
            attn_step<DK, false>(A0, kf, vf, qf0, sl2, nullptr, 0, 0, 0, quad);
            attn_step<DK, false>(A1, kf, vf, qf1, sl2, nullptr, 0, 0, 0, quad);
        }
        __syncthreads();
        if (sb + 1 < nsb) ATT_LWRITE((sb + 1) & 1);
        __syncthreads();
    }
#undef ATT_GLOAD
#undef ATT_LWRITE
    attn_store(A0, Ow + (size_t)r16 * 256 + quad * 4);
    attn_store(A1, Ow + (size_t)(16 + r16) * 256 + quad * 4);
}
DI void attn_item(const Ctx& C, int l, int kind, int seq, int hd, int qc) {
    const int wave = TIDX >> 6; const bool latent = seq >= 32;
    const int tb = latent ? TC + (seq - 32) * 2048 : seq * 256, koff = latent ? TC + (seq - 32) * 2560 : seq * 256;
    const int q0 = qc * 256 + wave * 32, tq = tb + q0;
    bf16_t* ys = C.w<bf16_t>(WS_HYS);
    const int nsb = latent ? 40 : 4;
    if (kind == 0) {
        attn_block<96, false>(C, C.w<bf16_t>(A_QM) + (size_t)tq * 384 + hd * 96, 384, C.w<bf16_t>(A_KM) + ((size_t)hd * NKEY + koff) * 96, C.w<bf16_t>(A_VTM) + (size_t)hd * 64 * NKEY + koff, nsb,
                              0.10206207261596575f, ys + ((size_t)1 * TT + tq) * 256 + hd * 64, nullptr, nullptr, nullptr, 0, 0, 0);
    } else if (kind == 1) {
        const int kvh = hd >> 1;
        attn_block<64, false>(C, C.w<bf16_t>(A_QG) + (size_t)tq * 256 + hd * 64, 256, C.w<bf16_t>(A_KG) + ((size_t)kvh * NKEY + koff) * 64, C.w<bf16_t>(A_VTG) + (size_t)kvh * 64 * NKEY + koff, nsb,
                              0.125f, ys + ((size_t)2 * TT + tq) * 256 + hd * 64, nullptr, nullptr, nullptr, 0, 0, 0);
    } else {
        const bf16_t* Q = C.w<bf16_t>(WS_ZB) + (size_t)tq * ZBW + 2080 + hd * 64; const bf16_t* K = C.w<bf16_t>(A_KN) + ((size_t)hd * NKEY + koff) * 64; const bf16_t* Vt = C.w<bf16_t>(A_VTN) + (size_t)hd * 64 * NKEY + koff;
        bf16_t* O = ys + ((size_t)3 * TT + tq) * 256 + hd * 64;
        if (!latent) attn_block<64, false>(C, Q, ZBW, K, Vt, 4, 0.125f, O, nullptr, nullptr, nullptr, 0, 0, 0);
        else { const int qr = q0 >> 6, qcolw = q0 & 63; int r0 = qr - 4; r0 = r0 < 0 ? 0 : (r0 > 24 ? 24 : r0);
            attn_block<64, true>(C, Q, ZBW, K + (size_t)2048 * 64, Vt + 2048, 8, 0.125f, O, K + (size_t)(r0 * 64) * 64, Vt + r0 * 64, C.in[34] + ((size_t)l * 4 + hd) * 15 * 31, qr, r0, qcolw); }
    }
}
constexpr int N_MIX = 64 + 128 + 64 + 1024 + 384;
DI void phase_mix(const Ctx& C, int l) {
    unsigned* ctr = C.w<unsigned>(WS_CTL) + 16 * l + 64 * C.rep; volatile int* sitem = (volatile int*)(C.smem + LDS_MAIN);
    for (;;) {
        __syncthreads();
        if (TIDX == 0) *sitem = (int)atomicAdd(ctr, 1u);
        __syncthreads();
        const int item = __builtin_amdgcn_readfirstlane(*sitem);
        if (item >= N_MIX) break;
        if (item < 64) { const int chain = item >> 2; scan_item(C, l, chain >> 3, 32 + ((chain >> 2) & 1), chain & 3, item & 3); }
        else if (item < 192) { const int i = item - 64, r = i & 63; attn_item(C, l, i >> 6, 32 + (r >> 5), (r >> 3) & 3, r & 7); }
        else if (item < 256) { const int i = item - 192; attn_item(C, l, 2, 32 + (i >> 5), (i >> 3) & 3, i & 7); }
        else if (item < 1280) { const int i = item - 256, chain = i >> 2; scan_item(C, l, chain >> 7, (chain >> 2) & 31, chain & 3, i & 3); }
        else { const int i = item - 1280, r = i & 127; attn_item(C, l, i >> 7, r >> 2, r & 3, 0); }
    }
}
DI void phase_post(const Ctx& C, int l) {
    const int lane = TIDX & 63, wave = TIDX >> 6, col = lane * 4, hd = lane >> 4;
    const f32x4 lg = *(const f32x4*)(C.in[26] + l * 256 + col), lb = *(const f32x4*)(C.in[27] + l * 256 + col);
    for (int t = BIDX * 8 + wave; t < TT; t += gridDim.x * 8) {
        const size_t o = (size_t)t * 256 + col;
        f32x4 y = *(const f32x4*)(C.w<float>(R_Y0) + o) + *(const f32x4*)(C.w<float>(R_Y1) + o);
        const float mu = rowsum16(y[0] + y[1] + y[2] + y[3]) * (1.0f / 64.0f);
        const f32x4 dlt = y - mu; const float var = rowsum16(dlt[0] * dlt[0] + dlt[1] * dlt[1] + dlt[2] * dlt[2] + dlt[3] * dlt[3]) * (1.0f / 64.0f);
        const float rs = rsqrtf(var + 64e-5f);
        const u32x2 vw = *(const u32x2*)(C.w<bf16_t>(WS_ZB) + (size_t)t * ZBW + 512 + col), gw = *(const u32x2*)(C.w<bf16_t>(R_G) + o);
        const f32x4 v = {__uint_as_float(vw.x << 16), __uint_as_float(vw.x & 0xffff0000u), __uint_as_float(vw.y << 16), __uint_as_float(vw.y & 0xffff0000u)};
        const f32x4 g = {__uint_as_float(gw.x << 16), __uint_as_float(gw.x & 0xffff0000u), __uint_as_float(gw.y << 16), __uint_as_float(gw.y & 0xffff0000u)};
        const float bs = C.w<float>(R_BS)[(size_t)t * 4 + hd];
        const f32x4 r = (dlt * rs * lg + lb + v * bs) * g;
        u32x2 w; w.x = pk2(r[0], r[1]); w.y = pk2(r[2], r[3]);
        *(u32x2*)(C.w<bf16_t>(WS_HYS) + o) = w;
    }
}

constexpr int N_PHASES = 2 + NLAY * 10;
template <int PH> DI void run_phase(const Ctx& C, PG8_LAS unsigned char* lds) {
    if constexpr (PH == 0) { phase_mod(C); __syncthreads(); phase_convert(C, 0); }
    else if constexpr (PH == 1) phase_rowprep(C, 0, 0);
    else {
        constexpr int l = (PH - 2) / 10, s = (PH - 2) % 10;
        if constexpr (s == 0) { pg8::Gemm g{C.w<bf16_t>(WS_HYS), C.w<bf16_t>(W_IN), TT, NZ, DM, 1 << 20, 0}; pg8::StaticOrder S; S.init(TT, NZ, gridDim.x, BIDX);
            EpiZ E{C.w<bf16_t>(WS_ZB), C.w<bf16_t>(WS_GL)}; pg8::gemm_phase<EpiZ, pg8::StaticOrder>(lds, g, S, E, nullptr); }
        else if constexpr (s == 1) phase_prep(C, l);
        else if constexpr (s == 2) phase_mix(C, l);
        else if constexpr (s == 3) phase_post(C, l);
        else if constexpr (s == 4) { pg8::Gemm g{C.w<bf16_t>(WS_HYS), C.w<bf16_t>(W_BR), TT, 4096, 256, 4, (size_t)TT * 256 * 2}; pg8::StaticOrder S; S.init(TT, 4096, gridDim.x, BIDX);
            EpiGate E{C.w<bf16_t>(WS_GL), C.w<bf16_t>(WS_GP)}; pg8::gemm_phase<EpiGate, pg8::StaticOrder>(lds, g, S, E, nullptr); }
        else if constexpr (s == 5) { pg8::Gemm g{C.w<bf16_t>(WS_GP), C.w<bf16_t>(W_O4), TT, 1024, 4096, 1 << 20, 0}; pg8::StaticOrder S; S.init(TT, 1024, gridDim.x, BIDX);
            pg8::EpiF32 E{C.w<float>(WS_MO), 1024, nullptr}; pg8::gemm_phase<pg8::EpiF32, pg8::StaticOrder>(lds, g, S, E, nullptr); }
        else if constexpr (s == 6) phase_rowprep(C, 1, l);
        else if constexpr (s == 7) { pg8::Gemm g{C.w<bf16_t>(WS_HYS), C.w<bf16_t>(W_GU), TT, 5632, DM, 1 << 20, 0}; pg8::StaticOrder S; S.init(TT, 5632, gridDim.x, BIDX);
            EpiSwiGLU E{C.w<bf16_t>(WS_GL)}; pg8::gemm_phase<EpiSwiGLU, pg8::StaticOrder>(lds, g, S, E, nullptr); }
        else if constexpr (s == 8) { pg8::Gemm g{C.w<bf16_t>(WS_GL), C.w<bf16_t>(W_DN), TT, 1024, FF, 1 << 20, 0}; pg8::StaticOrder S; S.init(TT, 1024, gridDim.x, BIDX);
            pg8::EpiF32 E{C.w<float>(WS_MO), 1024, nullptr}; pg8::gemm_phase<pg8::EpiF32, pg8::StaticOrder>(lds, g, S, E, nullptr); }
        else { phase_rowprep(C, 2, l); if constexpr (l + 1 < NLAY) { __syncthreads(); phase_convert(C, l + 1); } }
    }
}
template <int PH> DI void run_all(const Params& P, unsigned char* smem, cg::grid_group& grid, const XcdBarrier& xb) {
    if constexpr (PH < N_PHASES) {
#ifdef ONLY_S
        if constexpr (PH >= 2 && (PH - 2) % 10 == ONLY_S)
#endif
        if (P.ph_lo <= PH && PH < P.ph_hi) {
            Ctx C; { size_t z_ = 0; KIn i_ = (KIn)__builtin_amdgcn_kernarg_segment_ptr(); asm volatile("" : "+s"(z_), "+s"(i_)); C.ws = P.ws + z_; C.out = P.out + z_; C.in = i_; C.smem = smem; }
            run_phase<PH>(C, (PG8_LAS unsigned char*)smem);
#ifdef REP_MASK
            if constexpr (PH >= 2 && ((REP_MASK >> ((PH - 2) % 10)) & 1)) { for (int rep_ = 0; rep_ < REP_N; ++rep_) { grid.sync(); C.rep = rep_ + 1; run_phase<PH>(C, (PG8_LAS unsigned char*)smem); } }
#endif
            if (PH + 1 < P.ph_hi) { if constexpr (PH == 0) grid.sync(); else xcd_barrier(xb); }
        }
        run_all<PH + 1>(P, smem, grid, xb);
    }
}
__global__ void __launch_bounds__(NTHR) mega(Params P) {
    extern __shared__ __attribute__((aligned(16))) unsigned char smem[];
    cg::grid_group grid = cg::this_grid();
    volatile LAS unsigned* st = (volatile LAS unsigned*)(smem + LDS_MAIN + 16);
    if (threadIdx.x == 0) { st[0] = 0u; st[1] = 0u; }
    __syncthreads();
    const XcdBarrier xb = xcd_barrier_post((unsigned*)(P.ws + WS_BAR), st);
    run_all<0>(P, smem, grid, xb);
}

extern "C" void kernel_launch(void* const* d_in, const int* in_sizes, int n_in, void* d_out, int out_size, void* d_ws, size_t ws_size, hipStream_t stream) {
    static int grid_blocks = 0;
    if (grid_blocks == 0) {
        int dev = 0, cus = 0, per_cu = 0;
        hipGetDevice(&dev); hipDeviceGetAttribute(&cus, hipDeviceAttributeMultiprocessorCount, dev);
        if (hipFuncSetAttribute((const void*)mega, hipFuncAttributeMaxDynamicSharedMemorySize, LDS_BYTES) != hipSuccess) { fprintf(stderr, "hipFuncSetAttribute failed\n"); grid_blocks = -1; return; }
        hipOccupancyMaxActiveBlocksPerMultiprocessor(&per_cu, (const void*)mega, NTHR, LDS_BYTES);
        if (per_cu < 1) per_cu = 1;
        grid_blocks = cus * (per_cu > 1 ? 1 : per_cu);
        if (n_in != 40 || ws_size < WS_END) { fprintf(stderr, "kernel_launch: unexpected n_in %d or workspace %zu < %zu\n", n_in, ws_size, (size_t)WS_END); grid_blocks = -1; return; }
    }
    if (grid_blocks < 0) return;
    hipMemsetAsync((char*)d_ws + WS_CTL, 0, 32768, stream);
    Params P{};
    for (int i = 0; i < 40; ++i) P.in[i] = (const float*)d_in[i];
    P.out = (float*)d_out; P.ws = (unsigned char*)d_ws; P.ph_lo = 0; P.ph_hi = N_PHASES;
    void* args[] = {&P};
    hipError_t e = hipLaunchCooperativeKernel((const void*)mega, dim3(grid_blocks), dim3(NTHR), args, LDS_BYTES, stream);
    if (e != hipSuccess) fprintf(stderr, "cooperative launch failed: %s (grid %d)\n", hipGetErrorString(e), grid_blocks);
}
```
